# Optimizing an MI355X kernel written in HIP

```python
import jax, jax.numpy as jnp
from jax import lax
import numpy as np

D_MODEL = 1024
BATCH = 2
SEQ = 16384
DEPTH = 2

CHUNK = 64
HG_HEADS = 4
HG_DK = 128
HG_W = HG_HEADS * HG_DK
RET_HEADS = 4
RET_DK = 128
RET_DV = 256
RET_QK = RET_HEADS * RET_DK
RET_V = RET_HEADS * RET_DV
ML_HEADS = 4
ML_DK = 128
ML_DV = 256
ML_QK = ML_HEADS * ML_DK
ML_V = ML_HEADS * ML_DV
CONV_W = 4
D_FF = 4 * D_MODEL
EPS = 1e-6
GATE_CAP = 15.0
ROPE_BASE = 10000.0
N_EVEN = (DEPTH + 1) // 2
N_ODD = DEPTH // 2
EVEN_IN = 4 * HG_W + 2 * RET_QK + 2 * RET_V
EVEN_OUT = HG_W + RET_V
ODD_IN = 2 * ML_QK + 2 * ML_V + 2 * ML_HEADS

kernel_name = 'hybrid_hgrn2_retnet_mlstm'


def rmsnorm(x, g):
    xf = x.astype(jnp.float32)
    y = xf * lax.rsqrt(jnp.mean(xf * xf, axis=-1, keepdims=True) + EPS)
    return (y * g.astype(jnp.float32)).astype(x.dtype)


def head_rmsnorm(o, g, n_heads):
    b, s, w = o.shape
    return rmsnorm(o.reshape(b, s, n_heads, w // n_heads), g).reshape(b, s, w)


def to_chunks(x, n_heads):
    b, s, w = x.shape
    return x.reshape(b, s // CHUNK, CHUNK, n_heads, w // n_heads).transpose(1, 0, 3, 2, 4)


def gate_chunks(g):
    b, s, h = g.shape
    return g.reshape(b, s // CHUNK, CHUNK, h).transpose(1, 0, 3, 2)


def from_chunks(x):
    nc, b, h, c, d = x.shape
    return x.transpose(1, 0, 3, 2, 4).reshape(b, nc * c, h * d)


def rope(x, n_heads):
    b, s, w = x.shape
    dk = w // n_heads
    half = dk // 2
    xh = x.reshape(b, s, n_heads, dk)
    inv_freq = ROPE_BASE ** (-jnp.arange(half, dtype=jnp.float32) / half)
    ang = jnp.arange(s, dtype=jnp.float32)[:, None] * inv_freq[None, :]
    cos = jnp.cos(ang)[None, :, None, :]
    sin = jnp.sin(ang)[None, :, None, :]
    x1, x2 = xh[..., :half], xh[..., half:]
    return jnp.concatenate([x1 * cos - x2 * sin, x2 * cos + x1 * sin], axis=-1).reshape(b, s, w)


def hgrn2_scan(q, k, logf, v):
    nc, b, h, c, dk = q.shape
    dv = v.shape[-1]
    mask = jnp.tril(jnp.ones((c, c), dtype=bool))

    def step(state, inp):
        qc, kc, lfc, vc = inp
        bcum = jnp.cumsum(lfc, axis=2)
        diff = bcum[:, :, :, None, :] - bcum[:, :, None, :, :]
        decay = jnp.exp(jnp.where(mask[:, :, None], diff, -jnp.inf))
        scores = jnp.einsum('bhtd,bhsd,bhtsd->bhts', qc, kc, decay)
        out = jnp.einsum('bhts,bhsv->bhtv', scores, vc) \
            + jnp.einsum('bhtd,bhdv->bhtv', qc * jnp.exp(bcum), state)
        blast = bcum[:, :, -1, :]
        state = jnp.exp(blast)[..., None] * state \
            + jnp.einsum('bhsd,bhsv->bhdv', kc * jnp.exp(blast[:, :, None, :] - bcum), vc)
        return state, out

    init = jnp.zeros((b, h, dk, dv), jnp.float32)
    _, out = lax.scan(step, init, (q, k, logf, v))
    return out


def retention_scan(q, k, v):
    nc, b, h, c, dk = q.shape
    dv = v.shape[-1]
    mask = jnp.tril(jnp.ones((c, c), dtype=bool))
    lg = jnp.log1p(-jnp.exp2(-5.0 - jnp.arange(h, dtype=jnp.float32)))
    j = jnp.arange(c, dtype=jnp.float32)
    decay = jnp.where(mask, jnp.exp(lg[:, None, None] * (j[:, None] - j[None, :])), 0.0)
    q_decay = jnp.exp(lg[:, None] * (j + 1.0))[:, :, None]
    k_decay = jnp.exp(lg[:, None] * (c - 1.0 - j))[:, :, None]
    chunk_decay = jnp.exp(lg * c)[:, None, None]

    def step(state, inp):
        qc, kc, vc = inp
        scores = jnp.einsum('bhtd,bhsd->bhts', qc, kc) * decay
        out = jnp.einsum('bhts,bhsv->bhtv', scores, vc) \
            + jnp.einsum('bhtd,bhdv->bhtv', qc * q_decay, state)
        state = chunk_decay * state + jnp.einsum('bhsd,bhsv->bhdv', kc * k_decay, vc)
        return state, out

    init = jnp.zeros((b, h, dk, dv), jnp.float32)
    _, out = lax.scan(step, init, (q, k, v))
    return out


def mlstm_scan(q, k, v, lf, ig):
    nc, b, h, c, dk = q.shape
    dv = v.shape[-1]
    mask = jnp.tril(jnp.ones((c, c), dtype=bool))

    def step(carry, inp):
        cm, n, m = carry
        qc, kc, vc, lfc, igc = inp
        bcum = jnp.cumsum(lfc, axis=-1)
        logw = jnp.where(mask, bcum[..., :, None] - bcum[..., None, :] + igc[..., None, :], -jnp.inf)
        inter = bcum + m[..., None]
        m_row = jnp.maximum(inter, jnp.max(logw, axis=-1))
        w_intra = jnp.exp(logw - m_row[..., None])
        w_inter = jnp.exp(inter - m_row)
        scores = jnp.einsum('bhtd,bhsd->bhts', qc, kc) * w_intra
        num = jnp.einsum('bhts,bhsv->bhtv', scores, vc) \
            + w_inter[..., None] * jnp.einsum('bhtd,bhdv->bhtv', qc, cm)
        den = jnp.sum(scores, axis=-1) + w_inter * jnp.einsum('bhtd,bhd->bht', qc, n)
        out = num / jnp.maximum(jnp.abs(den), jnp.exp(-m_row))[..., None]
        blast = bcum[..., -1]
        logw_end = blast[..., None] - bcum + igc
        m_new = jnp.maximum(blast + m, jnp.max(logw_end, axis=-1))
        carry_scale = jnp.exp(blast + m - m_new)
        kw = kc * jnp.exp(logw_end - m_new[..., None])[..., None]
        cm = carry_scale[..., None, None] * cm + jnp.einsum('bhsd,bhsv->bhdv', kw, vc)
        n = carry_scale[..., None] * n + jnp.sum(kw, axis=2)
        return (cm, n, m_new), out

    init = (jnp.zeros((b, h, dk, dv), jnp.float32),
            jnp.zeros((b, h, dk), jnp.float32),
            jnp.zeros((b, h), jnp.float32))
    _, out = lax.scan(step, init, (q, k, v, lf, ig))
    return out


def causal_conv_silu(x, w, bias):
    s = x.shape[1]
    xp = jnp.pad(x, ((0, 0), (CONV_W - 1, 0), (0, 0)))
    y = sum(w[j].astype(jnp.float32) * xp[:, j:j + s, :] for j in range(CONV_W))
    return jax.nn.silu(y + bias.astype(jnp.float32))


def soft_cap(z):
    return GATE_CAP * jnp.tanh(z / GATE_CAP)


def even_mixer(h, w_in, lb, hg_norm_g, ret_norm_g, w_out):
    p = (h @ w_in).astype(jnp.float32)
    splits = [HG_W, 2 * HG_W, 3 * HG_W, 4 * HG_W, 4 * HG_W + RET_QK,
              4 * HG_W + 2 * RET_QK, 4 * HG_W + 2 * RET_QK + RET_V]
    hq, hf, hi, hgate, rq, rk, rv, rgate = jnp.split(p, splits, axis=-1)
    f = lb + (1.0 - lb) * jax.nn.sigmoid(hf)
    o_hg = from_chunks(hgrn2_scan(to_chunks(jax.nn.silu(hq), HG_HEADS), to_chunks(1.0 - f, HG_HEADS),
                                  to_chunks(jnp.log(f), HG_HEADS), to_chunks(hi, HG_HEADS)))
    o_hg = head_rmsnorm(o_hg, hg_norm_g, HG_HEADS) * jax.nn.silu(hgate)
    rq = rope(rq, RET_HEADS)
    rk = rope(rk, RET_HEADS) * RET_DK ** -0.5
    o_ret = from_chunks(retention_scan(to_chunks(rq, RET_HEADS), to_chunks(rk, RET_HEADS),
                                       to_chunks(rv, RET_HEADS)))
    o_ret = head_rmsnorm(o_ret, ret_norm_g, RET_HEADS) * jax.nn.silu(rgate)
    y = jnp.concatenate([o_hg, o_ret], axis=-1).astype(h.dtype)
    return y @ w_out


def odd_mixer(h, w_in, conv_w, conv_b, gate_b, ml_norm_g, w_out):
    p = (h @ w_in).astype(jnp.float32)
    splits = [2 * ML_QK, 2 * ML_QK + ML_V, 2 * ML_QK + 2 * ML_V, 2 * ML_QK + 2 * ML_V + ML_HEADS]
    qk, v, og, ig_pre, fg_pre = jnp.split(p, splits, axis=-1)
    qk = causal_conv_silu(qk, conv_w, conv_b)
    q, k = jnp.split(qk, 2, axis=-1)
    k = k * ML_DK ** -0.5
    gb = gate_b.astype(jnp.float32)
    ig = soft_cap(ig_pre + gb[0])
    lf = jax.nn.log_sigmoid(soft_cap(fg_pre + gb[1]))
    out = from_chunks(mlstm_scan(to_chunks(q, ML_HEADS), to_chunks(k, ML_HEADS), to_chunks(v, ML_HEADS),
                                 gate_chunks(lf), gate_chunks(ig)))
    y = (jax.nn.sigmoid(og) * head_rmsnorm(out, ml_norm_g, ML_HEADS)).astype(h.dtype)
    return y @ w_out


def sq_relu_mlp(h, w1, w2):
    return jnp.square(jax.nn.relu(h @ w1)) @ w2


def setup_inputs(seed: int = 0) -> dict:
    key = jax.random.key(seed)
    ks = jax.random.split(key, 16)
    f32 = jnp.float32

    def nrm(k, shape, fan_in):
        return jax.random.normal(k, shape, f32) * fan_in ** -0.5

    x = jax.random.normal(ks[0], (BATCH, SEQ, D_MODEL), f32)
    norm_g = 1.0 + 0.05 * jax.random.normal(ks[1], (DEPTH, 4, D_MODEL), f32)
    hg_lower_bound = 0.5 * jax.random.normal(ks[2], (DEPTH + 1, HG_W), f32)
    ev_w_in = nrm(ks[3], (N_EVEN, D_MODEL, EVEN_IN), D_MODEL)
    ev_hg_norm_g = 1.0 + 0.05 * jax.random.normal(ks[4], (N_EVEN, HG_DK), f32)
    ev_ret_norm_g = 1.0 + 0.05 * jax.random.normal(ks[5], (N_EVEN, RET_DV), f32)
    ev_w_out = nrm(ks[6], (N_EVEN, EVEN_OUT, D_MODEL), EVEN_OUT)
    od_w_in = nrm(ks[7], (N_ODD, D_MODEL, ODD_IN), D_MODEL)
    od_conv_w = nrm(ks[8], (N_ODD, CONV_W, 2 * ML_QK), CONV_W)
    od_conv_b = 0.02 * jax.random.normal(ks[9], (N_ODD, 2 * ML_QK), f32)
    kg1, kg2 = jax.random.split(ks[10])
    i_bias = 0.1 * jax.random.normal(kg1, (N_ODD, ML_HEADS), f32)
    f_bias = jnp.linspace(3.0, 6.0, ML_HEADS, dtype=f32)[None, :] + 0.1 * jax.random.normal(kg2, (N_ODD, ML_HEADS), f32)
    od_gate_b = jnp.stack([i_bias, f_bias], axis=1)
    od_ml_norm_g = 1.0 + 0.05 * jax.random.normal(ks[11], (N_ODD, ML_DV), f32)
    od_w_out = nrm(ks[12], (N_ODD, ML_V, D_MODEL), ML_V)
    mlp_w1 = nrm(ks[13], (DEPTH, D_MODEL, D_FF), D_MODEL)
    mlp_w2 = nrm(ks[14], (DEPTH, D_FF, D_MODEL), D_FF)
    return {'x': x, 'norm_g': norm_g, 'hg_lower_bound': hg_lower_bound,
            'ev_w_in': ev_w_in, 'ev_hg_norm_g': ev_hg_norm_g, 'ev_ret_norm_g': ev_ret_norm_g,
            'ev_w_out': ev_w_out, 'od_w_in': od_w_in, 'od_conv_w': od_conv_w, 'od_conv_b': od_conv_b,
            'od_gate_b': od_gate_b, 'od_ml_norm_g': od_ml_norm_g, 'od_w_out': od_w_out,
            'mlp_w1': mlp_w1, 'mlp_w2': mlp_w2}


def reference(x, norm_g, hg_lower_bound, ev_w_in, ev_hg_norm_g, ev_ret_norm_g, ev_w_out,
              od_w_in, od_conv_w, od_conv_b, od_gate_b, od_ml_norm_g, od_w_out, mlp_w1, mlp_w2):
    lower_bounds = jnp.cumsum(jax.nn.softmax(hg_lower_bound.astype(jnp.float32), axis=0), axis=0)
    for l in range(DEPTH):
        g = norm_g[l]
        h = rmsnorm(x, g[0])
        if l % 2 == 0:
            e = l // 2
            y = even_mixer(h, ev_w_in[e], lower_bounds[l], ev_hg_norm_g[e], ev_ret_norm_g[e], ev_w_out[e])
        else:
            o = l // 2
            y = odd_mixer(h, od_w_in[o], od_conv_w[o], od_conv_b[o], od_gate_b[o], od_ml_norm_g[o], od_w_out[o])
        x = x + rmsnorm(y, g[1])
        h = rmsnorm(x, g[2])
        x = x + rmsnorm(sq_relu_mlp(h, mlp_w1[l], mlp_w2[l]), g[3])
    return x
```

```cpp
#include <hip/hip_runtime.h>
#include <hip/hip_cooperative_groups.h>
#include <cstdio>
namespace cg = cooperative_groups;
__device__ __forceinline__ int ltid() { int t = threadIdx.x; asm volatile("" : "+v"(t)); return t; }
namespace pg8 {
#define PG8_LAS __attribute__((address_space(3)))
typedef unsigned short bf16_t;
typedef short bf16x8 __attribute__((ext_vector_type(8)));
typedef float f32x4 __attribute__((ext_vector_type(4)));
typedef unsigned u32x4 __attribute__((ext_vector_type(4)));
constexpr int BM = 256, BK = 64, HALF = 128, HTB = HALF * BK * 2  , STAGE_BYTES = 8 * HTB, NXCD = 8, WGM = 8;

__host__ __device__ __forceinline__ int lds_byte(int r, int c) { const int st = (r >> 4) * 2 + (c >> 5), rr = r & 15, cc = c & 31, ob = rr * 64 + cc * 2; return st * 1024 + (ob ^ (((ob >> 9) & 1) << 5)); }
__host__ __device__ __forceinline__ void stage_rc(int b, int& R, int& C) { const int st = b / 1024, sb = b % 1024, swz = sb ^ (((sb >> 9) & 1) << 5); R = (st >> 1) * 16 + swz / 64; C = (st & 1) * 32 + (swz % 64) / 2; }
__host__ __device__ __forceinline__ int perm32(int rho) { const int n = rho >> 4, i = rho & 15; return 8 * (i >> 2) + 4 * n + (i & 3); }

struct Unit { int pm, pn; };
struct Gemm { const bf16_t* A; const bf16_t* Bt; int M, N, K; };

struct StaticOrder {
    int nM, nN, nwg, G, c;
    __host__ __device__ void init(int M, int N, int G_, int c_) { nM = M / BM; nN = N / BM; nwg = nM * nN; G = G_; c = c_; }
    __host__ __device__ bool next(int i, Unit& u) const {
        const long L = (long)i * G + c; if (L >= nwg) return false;
        int wgid = (int)L; { const int q = nwg / NXCD, r = nwg % NXCD, xcd = wgid % NXCD, off = wgid / NXCD; wgid = (xcd < r ? xcd * (q + 1) : r * (q + 1) + (xcd - r) * q) + off; }
        const int nig = WGM * nN, gid = wgid / nig, fm = gid * WGM, gsz = (nM - fm) < WGM ? (nM - fm) : WGM;
        u.pm = fm + ((wgid % nig) % gsz); u.pn = (wgid % nig) / gsz; return true;
    }
    __device__ __forceinline__ void a_ready(const Unit&) const {}
    __device__ __forceinline__ void done(const Unit&) const {}
};
__device__ __forceinline__ unsigned cvt_pk_bf16(float lo, float hi) { unsigned r; asm volatile("v_cvt_pk_bf16_f32 %0, %1, %2" : "=v"(r) : "v"(lo), "v"(hi)); return r; }
struct EpiF32 {
    static constexpr bool PERM = false, AFTER_DRAIN = false;
    float* C; int ldc; const float* bias;
    __device__ __forceinline__ void operator()(const f32x4 (&acc)[2][2][4][2], const Unit& u, int wr, int wc, int fr, int fq) const {
        const int row0 = u.pm * BM + wr * 64 + fr, col0 = u.pn * BM + wc * 32 + 4 * fq;
        f32x4 bv[2][2];
#pragma unroll
        for (int bj = 0; bj < 2; ++bj)
#pragma unroll
            for (int n = 0; n < 2; ++n) bv[bj][n] = bias ? *(const f32x4*)(bias + col0 + bj * HALF + n * 16) : (f32x4){0.f, 0.f, 0.f, 0.f};
#pragma unroll
        for (int ai = 0; ai < 2; ++ai)
#pragma unroll
            for (int m = 0; m < 4; ++m) { float* rowp = C + (size_t)(row0 + ai * HALF + m * 16) * ldc + col0;
#pragma unroll
                for (int bj = 0; bj < 2; ++bj)
#pragma unroll
                    for (int n = 0; n < 2; ++n) *(f32x4*)(rowp + bj * HALF + n * 16) = acc[ai][bj][m][n] + bv[bj][n]; }
    }
};
template <class Epi, class Sched, bool STAMP = false>
__device__ __forceinline__ void gemm_phase(PG8_LAS unsigned char* lds, const Gemm g, const Sched& S, const Epi& E, unsigned long long* stamps) {
    const int tid = ltid(), wid = __builtin_amdgcn_readfirstlane(tid >> 6), lane = tid & 63, wr = wid >> 2, wc = wid & 3, fr = lane & 15, fq = lane >> 4;
    const int K = g.K, nt = K / BK;
    int ts_lo = 0, ts_hi = 0, nts = 0; const unsigned long long rt_entry = STAMP ? (unsigned long long)wall_clock64() : 0ull;
#define PG8_STAMP() do { if (STAMP && wid == 0 && nts < 64) { const unsigned long long _c = (unsigned long long)clock64(); \
        ts_lo = (lane == nts) ? (int)(unsigned)_c : ts_lo; ts_hi = (lane == nts) ? (int)(unsigned)(_c >> 32) : ts_hi; ++nts; } } while (0)
    PG8_STAMP();
    unsigned voffA[2], voffB[2];
#pragma unroll
    for (int i = 0; i < 2; ++i) { int R, C; stage_rc(tid * 16 + i * 8192, R, C); const int Rb = Epi::PERM ? ((R & ~31) + perm32(R & 31)) : R;
        voffA[i] = (unsigned)(R * K + C) * 2u; voffB[i] = (unsigned)(Rb * K + C) * 2u; }
    const size_t kstep = (size_t)(BK * 2);
    const size_t hstep = (size_t)HALF * K * 2;
    const size_t tstep = 2 * hstep;
    const unsigned ldsw = (unsigned)wid * 1024u;
    const int aoff = lds_byte(wr * 64 + fr, fq * 8), boff = lds_byte(wc * 32 + fr, fq * 8);
#define PG8_SA(b, h) (((b) * 2 + (h)) * HTB)
#define PG8_SB(b, h) ((4 + (b) * 2 + (h)) * HTB)
#define PG8_STAGE(bufoff, gbase, voff) do { _Pragma("unroll") for (int _i = 0; _i < 2; ++_i) \
        __builtin_amdgcn_global_load_lds((const unsigned*)((const char*)(gbase) + (voff)[_i]), (PG8_LAS unsigned*)(lds + (bufoff) + ldsw + _i * 8192), 16, 0, 0); } while (0)
#define PG8_LDA(dst, b, h) do { _Pragma("unroll") for (int m = 0; m < 4; ++m) _Pragma("unroll") for (int k = 0; k < 2; ++k) dst[m][k] = *(const PG8_LAS bf16x8*)(lds + PG8_SA(b, h) + aoff + m * 2048 + k * 1024); } while (0)
#define PG8_LDB(dst, b, h) do { _Pragma("unroll") for (int n = 0; n < 2; ++n) _Pragma("unroll") for (int k = 0; k < 2; ++k) dst[n][k] = *(const PG8_LAS bf16x8*)(lds + PG8_SB(b, h) + boff + n * 2048 + k * 1024); } while (0)
#define PG8_MMA(ai, bj, At, Bt) do { __builtin_amdgcn_s_setprio(1); _Pragma("unroll") for (int m = 0; m < 4; ++m) _Pragma("unroll") for (int n = 0; n < 2; ++n) _Pragma("unroll") for (int k = 0; k < 2; ++k) \
        acc[ai][bj][m][n] = __builtin_amdgcn_mfma_f32_16x16x32_bf16(Bt[n][k], At[m][k], acc[ai][bj][m][n], 0, 0, 0); __builtin_amdgcn_s_setprio(0); } while (0)
#define PG8_WAIT_V(n) asm volatile("s_waitcnt vmcnt(" #n ")" ::: "memory")
#define PG8_WAIT_L(n) asm volatile("s_waitcnt lgkmcnt(" #n ")" ::: "memory")
#define PG8_BAR __builtin_amdgcn_s_barrier()
#define PG8_SCHED __builtin_amdgcn_sched_barrier(0)
    Unit cur, nxt; int ui = 0;
    if (!S.next(0, cur)) return;
    f32x4 acc[2][2][4][2];
#pragma unroll
    for (int a = 0; a < 2; ++a)
#pragma unroll
        for (int b = 0; b < 2; ++b)
#pragma unroll
            for (int m = 0; m < 4; ++m)
#pragma unroll
                for (int n = 0; n < 2; ++n) acc[a][b][m][n] = (f32x4){0.f, 0.f, 0.f, 0.f};
    bf16x8 At[4][2], B0[2][2], B1[2][2];
    const char* cA = (const char*)g.A + (size_t)cur.pm * tstep; const char* cB = (const char*)g.Bt + (size_t)cur.pn * tstep;
    S.a_ready(cur);
    PG8_STAGE(PG8_SB(0, 0), cB, voffB); PG8_STAGE(PG8_SA(0, 0), cA, voffA); PG8_STAGE(PG8_SB(0, 1), cB + hstep, voffB); PG8_STAGE(PG8_SA(0, 1), cA + hstep, voffA);
    if (wr == 1) PG8_BAR;
    PG8_WAIT_V(4); PG8_BAR;
    PG8_STAGE(PG8_SB(1, 0), cB + kstep, voffB); PG8_STAGE(PG8_SA(1, 0), cA + kstep, voffA); PG8_STAGE(PG8_SB(1, 1), cB + hstep + kstep, voffB);
    PG8_WAIT_V(6); PG8_BAR;
    PG8_STAMP();
    for (;;) {
        const bool has_next = S.next(ui + 1, nxt);
        const char* nA = has_next ? (const char*)g.A + (size_t)nxt.pm * tstep : cA; const char* nB = has_next ? (const char*)g.Bt + (size_t)nxt.pn * tstep : cB;
        for (int t = 0; t < nt; t += 2) {
            const bool last = (t == nt - 2);
            const char* a1 = cA + (size_t)(t + 1) * kstep;
            const char* a2 = last ? nA : cA + (size_t)(t + 2) * kstep; const char* b2 = last ? nB : cB + (size_t)(t + 2) * kstep;
            const char* a3 = a2 + kstep; const char* b3 = b2 + kstep;
            if (last && has_next) S.a_ready(nxt);
            PG8_LDB(B0, 0, 0); PG8_SCHED; PG8_LDA(At, 0, 0); PG8_STAGE(PG8_SA(1, 1), a1 + hstep, voffA);
            PG8_WAIT_L(8); PG8_BAR; PG8_WAIT_L(0); PG8_MMA(0, 0, At, B0); PG8_BAR; PG8_SCHED;
            PG8_LDB(B1, 0, 1); PG8_STAGE(PG8_SB(0, 0), b2, voffB);
            PG8_BAR; PG8_WAIT_L(0); PG8_MMA(0, 1, At, B1); PG8_BAR;
            PG8_LDA(At, 0, 1); PG8_STAGE(PG8_SA(0, 0), a2, voffA);
            PG8_BAR; PG8_WAIT_L(0); PG8_MMA(1, 0, At, B0); PG8_BAR; PG8_SCHED;
            PG8_STAGE(PG8_SB(0, 1), b2 + hstep, voffB);
            PG8_WAIT_V(6); PG8_BAR; PG8_MMA(1, 1, At, B1); PG8_BAR;
            PG8_LDB(B0, 1, 0); PG8_SCHED; PG8_LDA(At, 1, 0); PG8_STAGE(PG8_SA(0, 1), a2 + hstep, voffA);
            PG8_WAIT_L(8); PG8_BAR; PG8_WAIT_L(0); PG8_MMA(0, 0, At, B0); PG8_BAR; PG8_SCHED;
            PG8_LDB(B1, 1, 1); PG8_STAGE(PG8_SB(1, 0), b3, voffB);
            PG8_BAR; PG8_WAIT_L(0); PG8_MMA(0, 1, At, B1); PG8_BAR;
            PG8_LDA(At, 1, 1); PG8_STAGE(PG8_SA(1, 0), a3, voffA);
            PG8_BAR; PG8_WAIT_L(0); PG8_MMA(1, 0, At, B0); PG8_BAR; PG8_SCHED;
            PG8_STAGE(PG8_SB(1, 1), b3 + hstep, voffB);
            PG8_WAIT_V(6); PG8_BAR; PG8_MMA(1, 1, At, B1); PG8_BAR;
        }
        PG8_STAMP();
        if constexpr (!Epi::AFTER_DRAIN) { E(acc, cur, wr, wc, fr, fq); S.done(cur); }
        PG8_STAMP();
        if (!has_next) break;
#pragma unroll
        for (int a = 0; a < 2; ++a)
#pragma unroll
            for (int b = 0; b < 2; ++b)
#pragma unroll
                for (int m = 0; m < 4; ++m)
#pragma unroll
                    for (int n = 0; n < 2; ++n) acc[a][b][m][n] = (f32x4){0.f, 0.f, 0.f, 0.f};
        cur = nxt; cA = nA; cB = nB; ++ui;
    }
    PG8_WAIT_V(0);
    if (wr == 0) PG8_BAR;
    PG8_BAR;
    if constexpr (Epi::AFTER_DRAIN) { E.fused(acc, cur, wr, wc, fr, fq, lds, wid, lane); S.done(cur); }
    PG8_STAMP();
    if (STAMP && wid == 0) { stamps[lane] = lane < nts ? (((unsigned long long)(unsigned)ts_hi << 32) | (unsigned)ts_lo) : 0ull;
        if (lane == 62) stamps[62] = rt_entry; if (lane == 63) stamps[63] = (unsigned long long)wall_clock64(); }
#undef PG8_STAMP
#undef PG8_SA
#undef PG8_SB
#undef PG8_STAGE
#undef PG8_LDA
#undef PG8_LDB
#undef PG8_MMA
#undef PG8_WAIT_V
#undef PG8_WAIT_L
#undef PG8_BAR
#undef PG8_SCHED
}
}

using pg8::bf16_t; using pg8::bf16x8; using pg8::f32x4; using pg8::u32x4;
typedef short s16x4 __attribute__((ext_vector_type(4)));
typedef unsigned u32x2 __attribute__((ext_vector_type(2)));
#define LAS __attribute__((address_space(3)))
#define DI __device__ __forceinline__
#define LAUNDER(ptr) asm volatile("" : "+s"(ptr))

constexpr int T_TOK = 32768, SEQ = 16384, DM = 1024;
constexpr int LDS_BYTES = 131072;
constexpr size_t MiB = 1ull << 20;
constexpr size_t W_IN0 = 0, W_OUT0 = 10 * MiB, W_UP0 = 13 * MiB, W_DN0 = 21 * MiB, W_IN1 = 29 * MiB, W_OUT1 = 35 * MiB, W_UP1 = 37 * MiB, W_DN1 = 45 * MiB;
constexpr size_t O_G32 = 53 * MiB, O_HGDEC = 54 * MiB, O_NLOC = 55 * MiB, O_NPREV = 56 * MiB, O_SCAL = 57 * MiB;
constexpr size_t O_P16_L0 = 58 * MiB, O_ST_L0 = 378 * MiB, O_H16A = 378 * MiB;
constexpr size_t O_Z32 = 58 * MiB, O_H16B = 186 * MiB, O_U16 = 250 * MiB;
constexpr size_t O_P16_L1 = 250 * MiB, O_ST_L1 = 58 * MiB, O_Y16_L1 = 442 * MiB;
constexpr size_t WS_NEED = 506 * MiB;

struct Params {
    const float *x, *norm_g, *hg_lb, *ev_w_in, *ev_hg_g, *ev_ret_g, *ev_w_out, *od_w_in, *od_conv_w, *od_conv_b, *od_gate_b, *od_ml_g, *od_w_out, *mlp_w1, *mlp_w2;
    float* out; unsigned char* ws; int phase_lo, phase_hi;
};

extern __shared__ __attribute__((aligned(16))) unsigned char smem[];

DI float bf2f(bf16_t b) { return __uint_as_float(((unsigned)b) << 16); }
DI bf16_t f2bf(float f) { unsigned u = __float_as_uint(f); u += 0x7fffu + ((u >> 16) & 1u); return (bf16_t)(u >> 16); }
DI unsigned pk2(float lo, float hi) { return (unsigned)f2bf(lo) | ((unsigned)f2bf(hi) << 16); }
DI float lo16(unsigned u) { return __uint_as_float(u << 16); }
DI float hi16(unsigned u) { return __uint_as_float(u & 0xffff0000u); }
DI float wave_sum(float v) {
#pragma unroll
    for (int o = 32; o >= 1; o >>= 1) v += __shfl_xor(v, o);
    return v;
}
DI float siluf(float x) { return x / (1.f + __expf(-x)); }
DI float sigmf(float x) { return 1.f / (1.f + __expf(-x)); }

struct EpiBf {
    static constexpr bool PERM = true, AFTER_DRAIN = false;
    bf16_t* O; int ldc; int relu2;
    __device__ __forceinline__ void operator()(const f32x4 (&acc)[2][2][4][2], const pg8::Unit& u, int wr, int wc, int fr, int fq) const {
        const int row0 = u.pm * 256 + wr * 64 + fr, col0 = u.pn * 256 + wc * 32 + 8 * fq;
#pragma unroll
        for (int ai = 0; ai < 2; ++ai)
#pragma unroll
            for (int m = 0; m < 4; ++m) { bf16_t* rowp = O + (size_t)(row0 + ai * 128 + m * 16) * ldc + col0;
#pragma unroll
                for (int bj = 0; bj < 2; ++bj) { f32x4 v0 = acc[ai][bj][m][0], v1 = acc[ai][bj][m][1];
                    if (relu2) {
#pragma unroll
                        for (int j = 0; j < 4; ++j) { float a = fmaxf(v0[j], 0.f), b = fmaxf(v1[j], 0.f); v0[j] = a * a; v1[j] = b * b; } }
                    u32x4 w; w.x = pg8::cvt_pk_bf16(v0[0], v0[1]); w.y = pg8::cvt_pk_bf16(v0[2], v0[3]); w.z = pg8::cvt_pk_bf16(v1[0], v1[1]); w.w = pg8::cvt_pk_bf16(v1[2], v1[3]);
                    *(u32x4*)(rowp + bj * 128) = w; } }
    }
};

DI void run_gemm(const Params& p, int ph) {
    const bf16_t* A; const bf16_t* Bt; int N, K, kind; void* out;
    unsigned char* ws = p.ws;
    switch (ph) {
        case 1:  A = (const bf16_t*)(ws + O_H16A); Bt = (const bf16_t*)(ws + W_IN0); N = 5120; K = 1024; kind = 0; out = ws + O_P16_L0; break;
        case 8:  A = (const bf16_t*)p.out;          Bt = (const bf16_t*)(ws + W_OUT0); N = 1024; K = 1536; kind = 2; out = ws + O_Z32; break;
        case 10: A = (const bf16_t*)(ws + O_H16B); Bt = (const bf16_t*)(ws + W_UP0); N = 4096; K = 1024; kind = 1; out = ws + O_U16; break;
        case 11: A = (const bf16_t*)(ws + O_U16);  Bt = (const bf16_t*)(ws + W_DN0); N = 1024; K = 4096; kind = 2; out = ws + O_Z32; break;
        case 13: A = (const bf16_t*)(ws + O_H16B); Bt = (const bf16_t*)(ws + W_IN1); N = 3072; K = 1024; kind = 0; out = ws + O_P16_L1; break;
        case 17: A = (const bf16_t*)(ws + O_Y16_L1); Bt = (const bf16_t*)(ws + W_OUT1); N = 1024; K = 1024; kind = 2; out = ws + O_Z32; break;
        case 19: A = (const bf16_t*)(ws + O_H16B); Bt = (const bf16_t*)(ws + W_UP1); N = 4096; K = 1024; kind = 1; out = ws + O_U16; break;
        default: A = (const bf16_t*)(ws + O_U16);  Bt = (const bf16_t*)(ws + W_DN1); N = 1024; K = 4096; kind = 2; out = ws + O_Z32; break;
    }
    pg8::Gemm g; g.A = A; g.Bt = Bt; g.M = T_TOK; g.N = N; g.K = K;
    pg8::StaticOrder S; S.init(T_TOK, N, (int)gridDim.x, (int)blockIdx.x);
    if (kind == 2) { pg8::EpiF32 e; e.C = (float*)out; e.ldc = N; e.bias = nullptr; pg8::gemm_phase<pg8::EpiF32, pg8::StaticOrder, false>((PG8_LAS unsigned char*)smem, g, S, e, nullptr); }
    else { EpiBf e; e.O = (bf16_t*)out; e.ldc = N; e.relu2 = kind; pg8::gemm_phase<EpiBf, pg8::StaticOrder, false>((PG8_LAS unsigned char*)smem, g, S, e, nullptr); }
}

DI void transpose_tile(const float* __restrict__ W, int ldw, bf16_t* __restrict__ Wt, int K, int k0, int n0) {
    float* t = (float*)smem;
    const int tid = ltid();
#pragma unroll
    for (int i = 0; i < 8; ++i) { const int idx = tid + i * 512, kk = idx >> 6, nn = idx & 63; t[kk * 65 + nn] = W[(size_t)(k0 + kk) * ldw + n0 + nn]; }
    __syncthreads();
#pragma unroll
    for (int i = 0; i < 4; ++i) { const int idx = tid + i * 512, nn = idx >> 5, kp = (idx & 31) * 2;
        *(unsigned*)(Wt + (size_t)(n0 + nn) * K + k0 + kp) = pk2(t[kp * 65 + nn], t[(kp + 1) * 65 + nn]); }
    __syncthreads();
}

DI void load_row(const float* src, int lane, f32x4 (&v)[4]) {
#pragma unroll
    for (int i = 0; i < 4; ++i) v[i] = *(const f32x4*)(src + lane * 4 + i * 256);
}
DI float row_ss(const f32x4 (&v)[4]) {
    float s = 0.f;
#pragma unroll
    for (int i = 0; i < 4; ++i) s += v[i][0] * v[i][0] + v[i][1] * v[i][1] + v[i][2] * v[i][2] + v[i][3] * v[i][3];
    return wave_sum(s);
}

template <int MODE, bool GATES>
DI void row_phase(const float* z, const float* xin, float* xo, const float* ga, const float* gb, bf16_t* hdst, const float* wg_src, float* g32) {
    const int tid = ltid(), lane = tid & 63, wid = tid >> 6;
    float* wgl = (float*)smem;
    if (GATES) {
        for (int idx = tid; idx < 1024 * 8; idx += 512) { const int k = idx >> 3, j = idx & 7; wgl[idx] = wg_src[(size_t)k * 3080 + 3072 + j]; }
        __syncthreads();
    }
    f32x4 gav[4], gbv[4];
    load_row(ga, lane, gav);
    if (MODE == 1) load_row(gb, lane, gbv);
    for (int row = blockIdx.x * 8 + wid; row < T_TOK; row += gridDim.x * 8) {
        f32x4 xv[4], hv[4];
        load_row(xin + (size_t)row * DM, lane, xv);
        if (MODE == 0) {
            const float r = rsqrtf(row_ss(xv) * (1.f / 1024.f) + 1e-6f);
#pragma unroll
            for (int i = 0; i < 4; ++i) hv[i] = xv[i] * r * gav[i];
        } else {
            f32x4 zv[4];
            load_row(z + (size_t)row * DM, lane, zv);
            const float rz = rsqrtf(row_ss(zv) * (1.f / 1024.f) + 1e-6f);
#pragma unroll
            for (int i = 0; i < 4; ++i) { xv[i] = xv[i] + zv[i] * rz * gav[i]; *(f32x4*)(xo + (size_t)row * DM + lane * 4 + i * 256) = xv[i]; }
            if (MODE == 1) {
                const float r = rsqrtf(row_ss(xv) * (1.f / 1024.f) + 1e-6f);
#pragma unroll
                for (int i = 0; i < 4; ++i) hv[i] = xv[i] * r * gbv[i];
            }
        }
        if (MODE != 2) {
#pragma unroll
            for (int i = 0; i < 4; ++i) { u32x2 w; w.x = pk2(hv[i][0], hv[i][1]); w.y = pk2(hv[i][2], hv[i][3]); *(u32x2*)(hdst + (size_t)row * DM + lane * 4 + i * 256) = w; }
        }
        if (GATES) {
            float gsum[8];
#pragma unroll
            for (int j = 0; j < 8; ++j) gsum[j] = 0.f;
#pragma unroll
            for (int i = 0; i < 4; ++i)
#pragma unroll
                for (int e = 0; e < 4; ++e) { const int k = lane * 4 + i * 256 + e; const f32x4 w0 = *(const f32x4*)(wgl + k * 8), w1 = *(const f32x4*)(wgl + k * 8 + 4); const float hvv = hv[i][e];
                    gsum[0] += hvv * w0[0]; gsum[1] += hvv * w0[1]; gsum[2] += hvv * w0[2]; gsum[3] += hvv * w0[3];
                    gsum[4] += hvv * w1[0]; gsum[5] += hvv * w1[1]; gsum[6] += hvv * w1[2]; gsum[7] += hvv * w1[3]; }
#pragma unroll
            for (int j = 0; j < 8; ++j) gsum[j] = wave_sum(gsum[j]);
            if (lane == 0) { f32x4 a = {gsum[0], gsum[1], gsum[2], gsum[3]}, b = {gsum[4], gsum[5], gsum[6], gsum[7]}; *(f32x4*)(g32 + (size_t)row * 8) = a; *(f32x4*)(g32 + (size_t)row * 8 + 4) = b; }
        }
    }
}

DI void prep_phase(const Params& p) {
    unsigned char* ws = p.ws;
    const int nt0 = 16 * 80, nt1 = nt0 + 24 * 16, nt2 = nt1 + 16 * 64, nt3 = nt2 + 64 * 16, nt4 = nt3 + 16 * 48, nt5 = nt4 + 16 * 16, nt6 = nt5 + 16 * 64, nt7 = nt6 + 64 * 16;
    for (int t = blockIdx.x; t < nt7; t += gridDim.x) {
        const float* W; int ldw, K, NT, local; bf16_t* Wt;
        if (t < nt0)      { W = p.ev_w_in;  ldw = 5120; K = 1024; NT = 80; Wt = (bf16_t*)(ws + W_IN0);  local = t; }
        else if (t < nt1) { W = p.ev_w_out; ldw = 1024; K = 1536; NT = 16; Wt = (bf16_t*)(ws + W_OUT0); local = t - nt0; }
        else if (t < nt2) { W = p.mlp_w1;   ldw = 4096; K = 1024; NT = 64; Wt = (bf16_t*)(ws + W_UP0);  local = t - nt1; }
        else if (t < nt3) { W = p.mlp_w2;   ldw = 1024; K = 4096; NT = 16; Wt = (bf16_t*)(ws + W_DN0);  local = t - nt2; }
        else if (t < nt4) { W = p.od_w_in;  ldw = 3080; K = 1024; NT = 48; Wt = (bf16_t*)(ws + W_IN1);  local = t - nt3; }
        else if (t < nt5) { W = p.od_w_out; ldw = 1024; K = 1024; NT = 16; Wt = (bf16_t*)(ws + W_OUT1); local = t - nt4; }
        else if (t < nt6) { W = p.mlp_w1 + (size_t)1024 * 4096; ldw = 4096; K = 1024; NT = 64; Wt = (bf16_t*)(ws + W_UP1); local = t - nt5; }
        else              { W = p.mlp_w2 + (size_t)4096 * 1024; ldw = 1024; K = 4096; NT = 16; Wt = (bf16_t*)(ws + W_DN1); local = t - nt6; }
        const int kt = local / NT, ntile = local % NT;
        transpose_tile(W, ldw, Wt, K, kt * 64, ntile * 64);
    }
    row_phase<0, false>(nullptr, p.x, nullptr, p.norm_g, nullptr, (bf16_t*)(ws + O_H16A), nullptr, nullptr);
}

constexpr int QS = 136, PS = 72;
constexpr int L_QE = 0, L_KE = 17408, L_VV = 34816, L_PP = 68608, L_SM = 77824;
constexpr int SM_ALPHA = 0, SM_BETA = 256, SM_WROW = 512, SM_DEN = 768, SM_SS = 1024, SM_EMR = 1280, SM_INVF = 1536, SM_SEG = 2048;

DI bf16x8 trfrag(const bf16_t* img, int rs, int s0, int c0, int lane) {
    const int g = lane >> 4, q = (lane & 15) >> 2, pp = lane & 3;
    const bf16_t* a = img + (s0 + g * 8 + q) * rs + c0 + 4 * pp;
    const s16x4 lo = __builtin_amdgcn_ds_read_tr16_b64_v4i16((LAS s16x4*)a);
    const s16x4 hi = __builtin_amdgcn_ds_read_tr16_b64_v4i16((LAS s16x4*)(a + 4 * rs));
    return __builtin_shufflevector(lo, hi, 0, 1, 2, 3, 4, 5, 6, 7);
}
#define MFMA16(a, b, c) __builtin_amdgcn_mfma_f32_16x16x32_bf16((a), (b), (c), 0, 0, 0)

template <int MIX> struct MixC { static constexpr int DV = (MIX == 0) ? 128 : 256; };

template <int MIX, bool PASS3>
DI void chunk_phase(const Params& p) {
    constexpr int DV = MixC<MIX>::DV, VS = DV + 8, NT = DV / 128, EPC = DV * 128, OS = DV + 4;
    const int tid = ltid(), lane = tid & 63, wid = tid >> 6, fr = lane & 15, fq = lane >> 4;
    unsigned char* ws = p.ws;
    bf16_t* QE = (bf16_t*)(smem + L_QE); bf16_t* KE = (bf16_t*)(smem + L_KE); bf16_t* VV = (bf16_t*)(smem + L_VV); bf16_t* PP = (bf16_t*)(smem + L_PP);
    float* alpha = (float*)(smem + L_SM + SM_ALPHA); float* beta = (float*)(smem + L_SM + SM_BETA); float* wrow = (float*)(smem + L_SM + SM_WROW);
    float* den = (float*)(smem + L_SM + SM_DEN); float* ssq = (float*)(smem + L_SM + SM_SS); float* emr = (float*)(smem + L_SM + SM_EMR);
    float* invf = (float*)(smem + L_SM + SM_INVF); float* segsum = (float*)(smem + L_SM + SM_SEG);
    float* OL = (float*)smem;
    const bf16_t* P16 = (const bf16_t*)(ws + (MIX == 2 ? O_P16_L1 : O_P16_L0));
    constexpr int LDP = (MIX == 2) ? 3072 : 5120;
    bf16_t* ST = (bf16_t*)(ws + (MIX == 2 ? O_ST_L1 : O_ST_L0));
    bf16_t* Y16 = (MIX == 2) ? (bf16_t*)(ws + O_Y16_L1) : (bf16_t*)p.out;
    constexpr int LDY = (MIX == 2) ? 1024 : 1536;
    float* G32 = (float*)(ws + O_G32); float* HGDEC = (float*)(ws + O_HGDEC); float* NLOC = (float*)(ws + O_NLOC); float* NPREV = (float*)(ws + O_NPREV);
    float* BLAST = (float*)(ws + O_SCAL); float* MLOC = BLAST + 2048; float* MPREV = BLAST + 4096;

    if (MIX == 1) { if (tid < 64) invf[tid] = powf(10000.f, -(float)tid / 64.f); }
    __syncthreads();

    for (int it = blockIdx.x; it < 2048; it += gridDim.x) {
        const int c = it & 255, bh = it >> 8, b = bh >> 2, h = bh & 3;
        const int r0 = b * SEQ + c * 64;
        bf16_t* STi = ST + (size_t)it * EPC;
        bf16x8 sb[NT][4];
        const int v0 = wid * (DV / 8);
        if (PASS3) {
#pragma unroll
            for (int n = 0; n < NT; ++n)
#pragma unroll
                for (int kk = 0; kk < 4; ++kk) sb[n][kk] = *(const bf16x8*)(STi + (size_t)(v0 + n * 16 + fr) * 128 + kk * 32 + fq * 8);
        }
        if (MIX == 0) {
            const int d = tid & 127, seg = tid >> 7, hd = h * 128 + d;
            const float a0 = p.hg_lb[hd], a1 = p.hg_lb[512 + hd], a2 = p.hg_lb[1024 + hd];
            const float mx = fmaxf(a0, fmaxf(a1, a2)); const float e0 = __expf(a0 - mx), e1 = __expf(a1 - mx), e2 = __expf(a2 - mx);
            const float lb = e0 / (e0 + e1 + e2);
            const bf16_t* base = P16 + (size_t)(r0 + seg * 16) * LDP;
            float bc[16], kk_[16]; float run = 0.f;
#pragma unroll
            for (int i = 0; i < 16; ++i) { const float xf = bf2f(base[(size_t)i * LDP + 512 + hd]); const float f = lb + (1.f - lb) * sigmf(xf); run += __logf(f); bc[i] = run; kk_[i] = 1.f - f; }
            segsum[seg * 128 + d] = run;
            __syncthreads();
            float off = 0.f, tot = 0.f;
#pragma unroll
            for (int s2 = 0; s2 < 4; ++s2) { const float v = segsum[s2 * 128 + d]; tot += v; if (s2 < seg) off += v; }
#pragma unroll
            for (int i = 0; i < 16; ++i) { const float bb = off + bc[i]; const int t = seg * 16 + i;
                if (PASS3) { const float q = siluf(bf2f(base[(size_t)i * LDP + hd]));
                    QE[t * QS + d] = f2bf(q * __expf(bb)); KE[t * QS + d] = f2bf(kk_[i] * __expf(fminf(-bb, 80.f))); }
                else KE[t * QS + d] = f2bf(kk_[i] * __expf(tot - bb)); }
            if (!PASS3 && seg == 0) HGDEC[(size_t)it * 128 + d] = __expf(tot);
#pragma unroll
            for (int j = 0; j < 2; ++j) { const int idx = tid + j * 512, t = idx >> 4, v8 = (idx & 15) * 8;
                *(u32x4*)(VV + t * VS + v8) = *(const u32x4*)(P16 + (size_t)(r0 + t) * LDP + 1024 + h * 128 + v8); }
        } else if (MIX == 1) {
            const float lg = log1pf(-exp2f(-5.f - (float)h));
            const int t = tid >> 3, i0 = (tid & 7) * 8, pos = c * 64 + t;
            const bf16_t* rowp = P16 + (size_t)(r0 + t) * LDP;
            const u32x4 k1 = *(const u32x4*)(rowp + 2560 + h * 128 + i0), k2 = *(const u32x4*)(rowp + 2560 + h * 128 + 64 + i0);
            u32x4 q1 = k1, q2 = k2;
            if (PASS3) { q1 = *(const u32x4*)(rowp + 2048 + h * 128 + i0); q2 = *(const u32x4*)(rowp + 2048 + h * 128 + 64 + i0); }
            const float ksc = 0.08838834764831845f * (PASS3 ? 1.f : __expf(lg * (float)(63 - t)));
            u32x4 qa, qb, ka, kb;
#pragma unroll
            for (int jj = 0; jj < 4; ++jj) {
                float cs[2], sn[2];
#pragma unroll
                for (int e = 0; e < 2; ++e) { double rev = (double)pos * (double)invf[i0 + jj * 2 + e] * 0.15915494309189535; rev -= rint(rev); const float frc = (float)rev;
                    sn[e] = __builtin_amdgcn_sinf(frc); cs[e] = __builtin_amdgcn_cosf(frc); }
                { const float x1l = lo16(k1[jj]), x1h = hi16(k1[jj]), x2l = lo16(k2[jj]), x2h = hi16(k2[jj]);
                  ka[jj] = pk2((x1l * cs[0] - x2l * sn[0]) * ksc, (x1h * cs[1] - x2h * sn[1]) * ksc);
                  kb[jj] = pk2((x2l * cs[0] + x1l * sn[0]) * ksc, (x2h * cs[1] + x1h * sn[1]) * ksc); }
                if (PASS3) { const float x1l = lo16(q1[jj]), x1h = hi16(q1[jj]), x2l = lo16(q2[jj]), x2h = hi16(q2[jj]);
                  qa[jj] = pk2(x1l * cs[0] - x2l * sn[0], x1h * cs[1] - x2h * sn[1]);
                  qb[jj] = pk2(x2l * cs[0] + x1l * sn[0], x2h * cs[1] + x1h * sn[1]); }
            }
            *(u32x4*)(KE + t * QS + i0) = ka; *(u32x4*)(KE + t * QS + 64 + i0) = kb;
            if (PASS3) { *(u32x4*)(QE + t * QS + i0) = qa; *(u32x4*)(QE + t * QS + 64 + i0) = qb; }
#pragma unroll
            for (int j = 0; j < 4; ++j) { const int idx = tid + j * 512, tt = idx >> 5, v8 = (idx & 31) * 8;
                *(u32x4*)(VV + tt * VS + v8) = *(const u32x4*)(P16 + (size_t)(r0 + tt) * LDP + 3072 + h * 256 + v8); }
            if (PASS3 && tid < 64) { alpha[tid] = lg * (float)tid; beta[tid] = -lg * (float)tid; wrow[tid] = __expf(lg * (float)(tid + 1)); }
        } else {
            const int r = r0 + lane;
            const float igp = G32[(size_t)r * 8 + h] + p.od_gate_b[h], fgp = G32[(size_t)r * 8 + 4 + h] + p.od_gate_b[4 + h];
            const float ig = 15.f * tanhf(igp * (1.f / 15.f)); const float fc = 15.f * tanhf(fgp * (1.f / 15.f));
            const float lf = -log1pf(expf(-fc));
            float bc = lf;
#pragma unroll
            for (int o = 1; o < 64; o <<= 1) { const float v = __shfl_up(bc, o); if (lane >= o) bc += v; }
            const float blast = __shfl(bc, 63);
            float ksc = 1.f;
            if (!PASS3) {
                const float lwe = blast - bc + ig; float ml = lwe;
#pragma unroll
                for (int o = 32; o >= 1; o >>= 1) ml = fmaxf(ml, __shfl_xor(ml, o));
                ksc = expf(lwe - ml);
                if (tid == 0) { BLAST[it] = blast; MLOC[it] = ml; }
            } else {
                const float mprev = MPREV[it]; const float inter = bc + mprev; const float bt = ig - bc; float bm = bt;
#pragma unroll
                for (int o = 1; o < 64; o <<= 1) { const float v = __shfl_up(bm, o); if (lane >= o) bm = fmaxf(bm, v); }
                const float mrow = fmaxf(inter, bc + bm);
                if (wid == 0) { alpha[lane] = bc - mrow; beta[lane] = bt; wrow[lane] = expf(inter - mrow); emr[lane] = expf(-mrow); den[lane] = 0.f; }
            }
#pragma unroll
            for (int which = (PASS3 ? 0 : 1); which < 2; ++which)
#pragma unroll
                for (int half = 0; half < 2; ++half) {
                    const int idx = tid + half * 512, tt = idx >> 4, c8 = (idx & 15) * 8, col = which * 512 + h * 128 + c8;
                    float acc[8];
                    { const f32x4 b0 = *(const f32x4*)(p.od_conv_b + col), b1 = *(const f32x4*)(p.od_conv_b + col + 4);
                      acc[0] = b0[0]; acc[1] = b0[1]; acc[2] = b0[2]; acc[3] = b0[3]; acc[4] = b1[0]; acc[5] = b1[1]; acc[6] = b1[2]; acc[7] = b1[3]; }
#pragma unroll
                    for (int jj = 0; jj < 4; ++jj) {
                        const int tok = c * 64 + tt - 3 + jj;
                        if (tok >= 0) {
                            const u32x4 xv = *(const u32x4*)(P16 + (size_t)(b * SEQ + tok) * LDP + col);
                            const f32x4 w0 = *(const f32x4*)(p.od_conv_w + jj * 1024 + col), w1 = *(const f32x4*)(p.od_conv_w + jj * 1024 + col + 4);
                            acc[0] += w0[0] * lo16(xv[0]); acc[1] += w0[1] * hi16(xv[0]); acc[2] += w0[2] * lo16(xv[1]); acc[3] += w0[3] * hi16(xv[1]);
                            acc[4] += w1[0] * lo16(xv[2]); acc[5] += w1[1] * hi16(xv[2]); acc[6] += w1[2] * lo16(xv[3]); acc[7] += w1[3] * hi16(xv[3]);
                        }
                    }
                    float sc = (which == 1) ? 0.08838834764831845f : 1.f;
                    if (!PASS3) sc *= __shfl(ksc, tt);
#pragma unroll
                    for (int e = 0; e < 8; ++e) acc[e] = siluf(acc[e]) * sc;
                    u32x4 w; w.x = pk2(acc[0], acc[1]); w.y = pk2(acc[2], acc[3]); w.z = pk2(acc[4], acc[5]); w.w = pk2(acc[6], acc[7]);
                    *(u32x4*)((which == 0 ? QE : KE) + tt * QS + c8) = w;
                }
#pragma unroll
            for (int j = 0; j < 4; ++j) { const int idx = tid + j * 512, tt = idx >> 5, v8 = (idx & 31) * 8;
                *(u32x4*)(VV + tt * VS + v8) = *(const u32x4*)(P16 + (size_t)(r0 + tt) * LDP + 1024 + h * 256 + v8); }
        }
        if (PASS3 && tid < 64) ssq[tid] = 0.f;
        __syncthreads();

        if (!PASS3) {
            constexpr int MT = DV / 128;
            f32x4 acc[MT][8];
#pragma unroll
            for (int m = 0; m < MT; ++m)
#pragma unroll
                for (int n = 0; n < 8; ++n) acc[m][n] = (f32x4){0.f, 0.f, 0.f, 0.f};
#pragma unroll
            for (int ks = 0; ks < 2; ++ks) {
                bf16x8 va[MT];
#pragma unroll
                for (int m = 0; m < MT; ++m) va[m] = trfrag(VV, VS, ks * 32, v0 + m * 16, lane);
#pragma unroll
                for (int n = 0; n < 8; ++n) { const bf16x8 kb = trfrag(KE, QS, ks * 32, n * 16, lane);
#pragma unroll
                    for (int m = 0; m < MT; ++m) acc[m][n] = MFMA16(kb, va[m], acc[m][n]); }
            }
#pragma unroll
            for (int m = 0; m < MT; ++m)
#pragma unroll
                for (int n = 0; n < 8; ++n) { u32x2 w; w.x = pk2(acc[m][n][0], acc[m][n][1]); w.y = pk2(acc[m][n][2], acc[m][n][3]);
                    *(u32x2*)(STi + (size_t)(v0 + m * 16 + fr) * 128 + n * 16 + fq * 4) = w; }
            if (MIX == 2 && tid < 128) { float s = 0.f;
#pragma unroll 8
                for (int t = 0; t < 64; ++t) s += bf2f(KE[t * QS + tid]);
                NLOC[(size_t)it * 128 + tid] = s; }
            __syncthreads();
        } else {
            if (MIX == 2) {
                const int t = tid >> 3, part = tid & 7; float s = 0.f;
#pragma unroll
                for (int e = 0; e < 16; ++e) s += bf2f(QE[t * QS + part * 16 + e]) * NPREV[(size_t)it * 128 + part * 16 + e];
                s += __shfl_xor(s, 1); s += __shfl_xor(s, 2); s += __shfl_xor(s, 4);
                if (part == 0) atomicAdd(&den[t], wrow[t] * s);
            }
            {
                const int ti = wid >> 1;
#pragma unroll
                for (int sj = 0; sj < 2; ++sj) {
                    const int si = (wid & 1) * 2 + sj;
                    f32x4 acc = {0.f, 0.f, 0.f, 0.f};
                    if (si <= ti) {
#pragma unroll
                        for (int kk = 0; kk < 4; ++kk) { const bf16x8 a = *(const bf16x8*)(QE + (ti * 16 + fr) * QS + kk * 32 + fq * 8); const bf16x8 bb = *(const bf16x8*)(KE + (si * 16 + fr) * QS + kk * 32 + fq * 8);
                            acc = MFMA16(a, bb, acc); }
                    }
                    const int s = si * 16 + fr; const float be = (MIX == 0) ? 0.f : beta[s];
#pragma unroll
                    for (int j = 0; j < 4; ++j) { const int t = ti * 16 + fq * 4 + j; float v = 0.f;
                        if (si <= ti && s <= t) v = (MIX == 0) ? acc[j] : acc[j] * __expf(alpha[t] + be);
                        PP[t * PS + s] = f2bf(v);
                        if (MIX == 2) { float rs = v; rs += __shfl_xor(rs, 1); rs += __shfl_xor(rs, 2); rs += __shfl_xor(rs, 4); rs += __shfl_xor(rs, 8);
                            if (fr == 0 && si <= ti) atomicAdd(&den[t], rs); } }
                }
            }
            __syncthreads();
            f32x4 acc[4][NT];
#pragma unroll
            for (int ti = 0; ti < 4; ++ti)
#pragma unroll
                for (int n = 0; n < NT; ++n) acc[ti][n] = (f32x4){0.f, 0.f, 0.f, 0.f};
#pragma unroll
            for (int kk = 0; kk < 4; ++kk)
#pragma unroll
                for (int ti = 0; ti < 4; ++ti) { const bf16x8 a = *(const bf16x8*)(QE + (ti * 16 + fr) * QS + kk * 32 + fq * 8);
#pragma unroll
                    for (int n = 0; n < NT; ++n) acc[ti][n] = MFMA16(a, sb[n][kk], acc[ti][n]); }
            if (MIX != 0) {
#pragma unroll
                for (int ti = 0; ti < 4; ++ti)
#pragma unroll
                    for (int j = 0; j < 4; ++j) { const float w = wrow[ti * 16 + fq * 4 + j];
#pragma unroll
                        for (int n = 0; n < NT; ++n) acc[ti][n][j] *= w; }
            }
#pragma unroll
            for (int ks = 0; ks < 2; ++ks) {
                bf16x8 vb[NT];
#pragma unroll
                for (int n = 0; n < NT; ++n) vb[n] = trfrag(VV, VS, ks * 32, v0 + n * 16, lane);
#pragma unroll
                for (int ti = 0; ti < 4; ++ti) { const bf16x8 a = *(const bf16x8*)(PP + (ti * 16 + fr) * PS + ks * 32 + fq * 8);
#pragma unroll
                    for (int n = 0; n < NT; ++n) acc[ti][n] = MFMA16(a, vb[n], acc[ti][n]); }
            }
            float ssl[4][4];
#pragma unroll
            for (int ti = 0; ti < 4; ++ti)
#pragma unroll
                for (int j = 0; j < 4; ++j) { const int t = ti * 16 + fq * 4 + j; float s = 0.f;
                    float inv = 1.f;
                    if (MIX == 2) inv = 1.f / fmaxf(fabsf(den[t]), emr[t]);
#pragma unroll
                    for (int n = 0; n < NT; ++n) { const float o = acc[ti][n][j] * inv; acc[ti][n][j] = o; s += o * o; }
                    ssl[ti][j] = s; }
            __syncthreads();
#pragma unroll
            for (int ti = 0; ti < 4; ++ti)
#pragma unroll
                for (int j = 0; j < 4; ++j) { const int t = ti * 16 + fq * 4 + j;
#pragma unroll
                    for (int n = 0; n < NT; ++n) OL[t * OS + v0 + n * 16 + fr] = acc[ti][n][j];
                    float s = ssl[ti][j]; s += __shfl_xor(s, 1); s += __shfl_xor(s, 2); s += __shfl_xor(s, 4); s += __shfl_xor(s, 8);
                    if (fr == 0) atomicAdd(&ssq[t], s); }
            __syncthreads();
            {
                const float* gn = (MIX == 0) ? p.ev_hg_g : (MIX == 1) ? p.ev_ret_g : p.od_ml_g;
                constexpr int gcol0 = (MIX == 0) ? 1536 : (MIX == 1) ? 4096 : 2048;
                constexpr int ycol0 = (MIX == 1) ? 512 : 0;
                constexpr int VPR = DV / 8;
#pragma unroll
                for (int j = 0; j < (64 * VPR) / 512; ++j) {
                    const int idx = tid + j * 512, t = idx / VPR, v8 = (idx % VPR) * 8;
                    const float rstd = rsqrtf(ssq[t] * (1.f / (float)DV) + 1e-6f);
                    const u32x4 gt = *(const u32x4*)(P16 + (size_t)(r0 + t) * LDP + gcol0 + h * DV + v8);
                    const f32x4 o0 = *(const f32x4*)(OL + t * OS + v8), o1 = *(const f32x4*)(OL + t * OS + v8 + 4);
                    const f32x4 g0 = *(const f32x4*)(gn + v8), g1 = *(const f32x4*)(gn + v8 + 4);
                    float gv[8] = {lo16(gt[0]), hi16(gt[0]), lo16(gt[1]), hi16(gt[1]), lo16(gt[2]), hi16(gt[2]), lo16(gt[3]), hi16(gt[3])};
                    float y[8];
#pragma unroll
                    for (int e = 0; e < 8; ++e) { const float o = (e < 4) ? o0[e & 3] : o1[e & 3]; const float g = (e < 4) ? g0[e & 3] : g1[e & 3];
                        const float act = (MIX == 2) ? sigmf(gv[e]) : siluf(gv[e]);
                        y[e] = o * rstd * g * act; }
                    u32x4 w; w.x = pk2(y[0], y[1]); w.y = pk2(y[2], y[3]); w.z = pk2(y[4], y[5]); w.w = pk2(y[6], y[7]);
                    *(u32x4*)(Y16 + (size_t)(r0 + t) * LDY + ycol0 + h * DV + v8) = w;
                }
            }
            __syncthreads();
        }
    }
}

template <int MIX>
DI void scan_phase(const Params& p) {
    constexpr int DV = MixC<MIX>::DV, EPC = DV * 128, HPC = EPC / 2;
    unsigned char* ws = p.ws;
    bf16_t* ST = (bf16_t*)(ws + (MIX == 2 ? O_ST_L1 : O_ST_L0));
    const float* HGDEC = (const float*)(ws + O_HGDEC); const float* NLOC = (const float*)(ws + O_NLOC); float* NPREV = (float*)(ws + O_NPREV);
    const float* BLAST = (const float*)(ws + O_SCAL); const float* MLOC = BLAST + 2048; float* MPREV = (float*)(ws + O_SCAL) + 4096;
    for (int e = blockIdx.x * 512 + ltid(); e < 8 * HPC; e += gridDim.x * 512) {
        const int chain = e / HPC, off = (e % HPC) * 2, d = off & 127, v = off >> 7;
        bf16_t* base = ST + (size_t)chain * 256 * EPC + off;
        float s0 = 0.f, s1 = 0.f, m = 0.f, n0 = 0.f, n1 = 0.f;
        float cd = 1.f;
        if (MIX == 1) cd = __expf(64.f * log1pf(-exp2f(-5.f - (float)(chain & 3))));
        for (int c0 = 0; c0 < 256; c0 += 8) {
            unsigned hv[8]; float dx[8], dy[8];
#pragma unroll
            for (int u = 0; u < 8; ++u) { hv[u] = *(const unsigned*)(base + (size_t)(c0 + u) * EPC);
                if (MIX == 0) { const float2 dd = *(const float2*)(HGDEC + (size_t)(chain * 256 + c0 + u) * 128 + d); dx[u] = dd.x; dy[u] = dd.y; } }
#pragma unroll
            for (int u = 0; u < 8; ++u) {
                const int ci = chain * 256 + c0 + u;
                *(unsigned*)(base + (size_t)(c0 + u) * EPC) = pk2(s0, s1);
                const float h0 = lo16(hv[u]), h1 = hi16(hv[u]);
                if (MIX == 0) { s0 = dx[u] * s0 + h0; s1 = dy[u] * s1 + h1; }
                else if (MIX == 1) { s0 = cd * s0 + h0; s1 = cd * s1 + h1; }
                else {
                    const float bl = BLAST[ci], ml = MLOC[ci]; const float mn = fmaxf(bl + m, ml); const float sp = expf(bl + m - mn), sl = expf(ml - mn);
                    if (v == 0) { *(float2*)(NPREV + (size_t)ci * 128 + d) = make_float2(n0, n1); const float2 nl = *(const float2*)(NLOC + (size_t)ci * 128 + d);
                        n0 = sp * n0 + sl * nl.x; n1 = sp * n1 + sl * nl.y; if (d == 0) MPREV[ci] = m; }
                    s0 = sp * s0 + sl * h0; s1 = sp * s1 + sl * h1; m = mn;
                }
            }
        }
    }
}

#ifndef PH_MASK
#define PH_MASK 0x3fffff
#endif
#define EN(n) if constexpr (((PH_MASK) >> (n)) & 1)
DI void run_phase(const Params& p, int ph) {
    unsigned char* ws = p.ws;
    switch (ph) {
        case 0: EN(0) prep_phase(p); break;
        case 1: case 8: case 10: case 11: case 13: case 17: case 19: case 20: EN(1) run_gemm(p, ph); break;
        case 2: EN(2) chunk_phase<0, false>(p); break;
        case 3: EN(3) scan_phase<0>(p); break;
        case 4: EN(4) chunk_phase<0, true>(p); break;
        case 5: EN(5) chunk_phase<1, false>(p); break;
        case 6: EN(6) scan_phase<1>(p); break;
        case 7: EN(7) chunk_phase<1, true>(p); break;
        case 9:  EN(9) row_phase<1, false>((const float*)(ws + O_Z32), p.x, p.out, p.norm_g + 1 * 1024, p.norm_g + 2 * 1024, (bf16_t*)(ws + O_H16B), nullptr, nullptr); break;
        case 12: EN(12) row_phase<1, true>((const float*)(ws + O_Z32), p.out, p.out, p.norm_g + 3 * 1024, p.norm_g + 4 * 1024, (bf16_t*)(ws + O_H16B), p.od_w_in, (float*)(ws + O_G32)); break;
        case 14: EN(14) chunk_phase<2, false>(p); break;
        case 15: EN(15) scan_phase<2>(p); break;
        case 16: EN(16) chunk_phase<2, true>(p); break;
        case 18: EN(18) row_phase<1, false>((const float*)(ws + O_Z32), p.out, p.out, p.norm_g + 5 * 1024, p.norm_g + 6 * 1024, (bf16_t*)(ws + O_H16B), nullptr, nullptr); break;
        case 21: EN(21) row_phase<2, false>((const float*)(ws + O_Z32), p.out, p.out, p.norm_g + 7 * 1024, nullptr, nullptr, nullptr, nullptr); break;
        default: break;
    }
}
constexpr int N_PHASES = 22;

__global__ void __launch_bounds__(512, 2) mega(Params p) {
    cg::grid_group grid = cg::this_grid();
    for (int ph = p.phase_lo; ph < p.phase_hi; ++ph) {
        Params q = p;
        LAUNDER(q.x); LAUNDER(q.norm_g); LAUNDER(q.hg_lb); LAUNDER(q.ev_w_in); LAUNDER(q.ev_hg_g); LAUNDER(q.ev_ret_g); LAUNDER(q.ev_w_out); LAUNDER(q.od_w_in);
        LAUNDER(q.od_conv_w); LAUNDER(q.od_conv_b); LAUNDER(q.od_gate_b); LAUNDER(q.od_ml_g); LAUNDER(q.od_w_out); LAUNDER(q.mlp_w1); LAUNDER(q.mlp_w2); LAUNDER(q.out); LAUNDER(q.ws);
        run_phase(q, ph);
        if (ph + 1 < p.phase_hi) grid.sync();
    }
}

extern "C" void kernel_launch(void* const* d_in, const int* in_sizes, int n_in, void* d_out, int out_size, void* d_ws, size_t ws_size, hipStream_t stream) {
    static int grid_blocks = 0;
    if (!grid_blocks) {
        int dev = 0, cus = 0, per_cu = 0;
        hipGetDevice(&dev);
        hipDeviceGetAttribute(&cus, hipDeviceAttributeMultiprocessorCount, dev);
        hipFuncSetAttribute((const void*)mega, hipFuncAttributeMaxDynamicSharedMemorySize, LDS_BYTES);
        hipOccupancyMaxActiveBlocksPerMultiprocessor(&per_cu, mega, 512, LDS_BYTES);
        if (per_cu > 1) per_cu = 1;
        grid_blocks = cus * per_cu;
        if (grid_blocks <= 0) { fprintf(stderr, "occupancy query failed (cus %d per_cu %d)\n", cus, per_cu); grid_blocks = 0; return; }
    }
    if (ws_size < WS_NEED) { fprintf(stderr, "workspace too small: %zu < %zu\n", ws_size, (size_t)WS_NEED); return; }
    Params p{};
    p.x = (const float*)d_in[0]; p.norm_g = (const float*)d_in[1]; p.hg_lb = (const float*)d_in[2]; p.ev_w_in = (const float*)d_in[3]; p.ev_hg_g = (const float*)d_in[4];
    p.ev_ret_g = (const float*)d_in[5]; p.ev_w_out = (const float*)d_in[6]; p.od_w_in = (const float*)d_in[7]; p.od_conv_w = (const float*)d_in[8]; p.od_conv_b = (const float*)d_in[9];
    p.od_gate_b = (const float*)d_in[10]; p.od_ml_g = (const float*)d_in[11]; p.od_w_out = (const float*)d_in[12]; p.mlp_w1 = (const float*)d_in[13]; p.mlp_w2 = (const float*)d_in[14];
    p.out = (float*)d_out; p.ws = (unsigned char*)d_ws; p.phase_lo = 0; p.phase_hi = N_PHASES;
    void* args[] = {&p};
    hipError_t e = hipLaunchCooperativeKernel((const void*)mega, dim3(grid_blocks), dim3(512), args, LDS_BYTES, stream);
    if (e != hipSuccess) fprintf(stderr, "cooperative launch failed: %s (grid %d)\n", hipGetErrorString(e), grid_blocks);
}
```

```cpp
#include <hip/hip_runtime.h>
#include <hip/hip_cooperative_groups.h>
#include <cstdio>
namespace cg = cooperative_groups;
#define LAS __attribute__((address_space(3)))

#define XB_TMO      128
#define XB_XCNT(j)  (256  + 64 * (j))
#define XB_XSUB(j)  (1280 + 64 * (j))
#define XB_XGEN(j)  (2304 + 64 * (j))
#define XB_TOP      3328
#define XB_TOPGEN   3392
#define XCD_BAR_WORDS 3456
#define XB_SPIN_CAP (1u << 18)

__device__ __forceinline__ unsigned xb_ld(unsigned* p)              { return __hip_atomic_load(p, __ATOMIC_RELAXED, __HIP_MEMORY_SCOPE_AGENT); }
__device__ __forceinline__ unsigned xb_add(unsigned* p, unsigned v) { return __hip_atomic_fetch_add(p, v, __ATOMIC_RELAXED, __HIP_MEMORY_SCOPE_AGENT); }
__device__ __forceinline__ unsigned xb_xcc_id() { return (unsigned)__builtin_amdgcn_s_getreg((3 << 11) | 20) & 0xFu; }
#define XB_SPIN(cond, bar) do { unsigned _sp = 0; while (cond) { __builtin_amdgcn_s_sleep(1); \
    if ((++_sp & 255u) == 0u) { if (xb_ld(&(bar)[XB_TMO])) break; if (_sp > XB_SPIN_CAP) { atomicAdd(&(bar)[XB_TMO], 1u); break; } } } } while (0)

struct XcdBarrier {
    unsigned* bar; unsigned x;
    volatile LAS unsigned* st;
};

__device__ __forceinline__ XcdBarrier xcd_barrier_post(unsigned* bar, volatile LAS unsigned* st) {
    XcdBarrier b; b.bar = bar; b.x = xb_xcc_id(); b.st = st;
    if (threadIdx.x == 0) (void)xb_add(&bar[XB_XCNT(b.x)], 1u);
    return b;
}
__device__ __forceinline__ void xcd_barrier_complete(unsigned* bar, unsigned x, unsigned& nloc, unsigned& nx) {
    const unsigned G = gridDim.x * gridDim.y * gridDim.z;
    unsigned sum, cnt, mine, sp = 0u;
    for (;;) {
        sum = 0u; cnt = 0u; mine = 0u;
#pragma unroll
        for (unsigned j = 0; j < 16; ++j) { const unsigned c = xb_ld(&bar[XB_XCNT(j)]); sum += c; cnt += (c > 0u) ? 1u : 0u; mine = (j == x) ? c : mine; }
        if (sum == G) break;
        __builtin_amdgcn_s_sleep(1);
        if ((++sp & 255u) == 0u) { if (xb_ld(&bar[XB_TMO])) break; if (sp > XB_SPIN_CAP) { atomicAdd(&bar[XB_TMO], 1u); break; } }
    }
    nloc = mine > 0u ? mine : 1u; nx = cnt > 0u ? cnt : 1u;
}

__device__ __forceinline__ void xcd_barrier(const XcdBarrier& b) {
    asm volatile("s_waitcnt vmcnt(0)" ::: "memory");
    __syncthreads();
    if (threadIdx.x == 0) {
        unsigned* bar = b.bar;
        __builtin_amdgcn_s_waitcnt(0);
        unsigned nloc = b.st[0], nx = b.st[1];
        if (nloc == 0u) { xcd_barrier_complete(bar, b.x, nloc, nx); b.st[0] = nloc; b.st[1] = nx; }
        const unsigned old = xb_add(&bar[XB_XSUB(b.x)], 1u);
        const unsigned gen = old / nloc;
        if (old + 1u == (gen + 1u) * nloc) {
            __builtin_amdgcn_fence(__ATOMIC_RELEASE, "agent");
            asm volatile("s_waitcnt vmcnt(0)" ::: "memory");
            const unsigned og = xb_add(&bar[XB_TOP], 1u);
            const unsigned tg = og / nx;
            if (og + 1u == (tg + 1u) * nx) xb_add(&bar[XB_TOPGEN], 1u);
            else XB_SPIN(xb_ld(&bar[XB_TOPGEN]) == tg, bar);
            __builtin_amdgcn_fence(__ATOMIC_ACQUIRE, "agent");
            xb_add(&bar[XB_XGEN(b.x)], 1u);
            asm volatile("s_waitcnt vmcnt(0)" ::: "memory");
        } else {
            XB_SPIN(xb_ld(&bar[XB_XGEN(b.x)]) == gen, bar);
            __builtin_amdgcn_fence(__ATOMIC_ACQUIRE, "agent");
            asm volatile("s_waitcnt vmcnt(0)" ::: "memory");
        }
    }
    __syncthreads();
}
__device__ __forceinline__ int ltid() { int t = threadIdx.x; asm volatile("" : "+v"(t)); return t; }
namespace pg8 {
#define PG8_LAS __attribute__((address_space(3)))
typedef unsigned short bf16_t;
typedef short bf16x8 __attribute__((ext_vector_type(8)));
typedef float f32x4 __attribute__((ext_vector_type(4)));
typedef unsigned u32x4 __attribute__((ext_vector_type(4)));
constexpr int BM = 256, BK = 64, HALF = 128, HTB = HALF * BK * 2  , STAGE_BYTES = 8 * HTB, NXCD = 8, WGM = 8;

__host__ __device__ __forceinline__ int lds_byte(int r, int c) { const int st = (r >> 4) * 2 + (c >> 5), rr = r & 15, cc = c & 31, ob = rr * 64 + cc * 2; return st * 1024 + (ob ^ (((ob >> 9) & 1) << 5)); }
__host__ __device__ __forceinline__ void stage_rc(int b, int& R, int& C) { const int st = b / 1024, sb = b % 1024, swz = sb ^ (((sb >> 9) & 1) << 5); R = (st >> 1) * 16 + swz / 64; C = (st & 1) * 32 + (swz % 64) / 2; }
__host__ __device__ __forceinline__ int perm32(int rho) { const int n = rho >> 4, i = rho & 15; return 8 * (i >> 2) + 4 * n + (i & 3); }

struct Unit { int pm, pn; };
struct Gemm { const bf16_t* A; const bf16_t* Bt; int M, N, K; };

struct StaticOrder {
    int nM, nN, nwg, G, c;
    __host__ __device__ void init(int M, int N, int G_, int c_) { nM = M / BM; nN = N / BM; nwg = nM * nN; G = G_; c = c_; }
    __host__ __device__ bool next(int i, Unit& u) const {
        const long L = (long)i * G + c; if (L >= nwg) return false;
        int wgid = (int)L; { const int q = nwg / NXCD, r = nwg % NXCD, xcd = wgid % NXCD, off = wgid / NXCD; wgid = (xcd < r ? xcd * (q + 1) : r * (q + 1) + (xcd - r) * q) + off; }
        const int nig = WGM * nN, gid = wgid / nig, fm = gid * WGM, gsz = (nM - fm) < WGM ? (nM - fm) : WGM;
        u.pm = fm + ((wgid % nig) % gsz); u.pn = (wgid % nig) / gsz; return true;
    }
    __device__ __forceinline__ void a_ready(const Unit&) const {}
    __device__ __forceinline__ void done(const Unit&) const {}
};
__device__ __forceinline__ unsigned cvt_pk_bf16(float lo, float hi) { unsigned r; asm volatile("v_cvt_pk_bf16_f32 %0, %1, %2" : "=v"(r) : "v"(lo), "v"(hi)); return r; }
struct EpiF32 {
    static constexpr bool PERM = false, AFTER_DRAIN = false;
    float* C; int ldc; const float* bias;
    __device__ __forceinline__ void operator()(const f32x4 (&acc)[2][2][4][2], const Unit& u, int wr, int wc, int fr, int fq) const {
        const int row0 = u.pm * BM + wr * 64 + fr, col0 = u.pn * BM + wc * 32 + 4 * fq;
        f32x4 bv[2][2];
#pragma unroll
        for (int bj = 0; bj < 2; ++bj)
#pragma unroll
            for (int n = 0; n < 2; ++n) bv[bj][n] = bias ? *(const f32x4*)(bias + col0 + bj * HALF + n * 16) : (f32x4){0.f, 0.f, 0.f, 0.f};
#pragma unroll
        for (int ai = 0; ai < 2; ++ai)
#pragma unroll
            for (int m = 0; m < 4; ++m) { float* rowp = C + (size_t)(row0 + ai * HALF + m * 16) * ldc + col0;
#pragma unroll
                for (int bj = 0; bj < 2; ++bj)
#pragma unroll
                    for (int n = 0; n < 2; ++n) *(f32x4*)(rowp + bj * HALF + n * 16) = acc[ai][bj][m][n] + bv[bj][n]; }
    }
};
template <class Epi, class Sched, bool STAMP = false>
__device__ __forceinline__ void gemm_phase(PG8_LAS unsigned char* lds, const Gemm g, const Sched& S, const Epi& E, unsigned long long* stamps) {
    const int tid = ltid(), wid = __builtin_amdgcn_readfirstlane(tid >> 6), lane = tid & 63, wr = wid >> 2, wc = wid & 3, fr = lane & 15, fq = lane >> 4;
    const int K = g.K, nt = K / BK;
    int ts_lo = 0, ts_hi = 0, nts = 0; const unsigned long long rt_entry = STAMP ? (unsigned long long)wall_clock64() : 0ull;
#define PG8_STAMP() do { if (STAMP && wid == 0 && nts < 64) { const unsigned long long _c = (unsigned long long)clock64(); \
        ts_lo = (lane == nts) ? (int)(unsigned)_c : ts_lo; ts_hi = (lane == nts) ? (int)(unsigned)(_c >> 32) : ts_hi; ++nts; } } while (0)
    PG8_STAMP();
    unsigned voffA[2], voffB[2];
#pragma unroll
    for (int i = 0; i < 2; ++i) { int R, C; stage_rc(tid * 16 + i * 8192, R, C); const int Rb = Epi::PERM ? ((R & ~31) + perm32(R & 31)) : R;
        voffA[i] = (unsigned)(R * K + C) * 2u; voffB[i] = (unsigned)(Rb * K + C) * 2u; }
    const size_t kstep = (size_t)(BK * 2);
    const size_t hstep = (size_t)HALF * K * 2;
    const size_t tstep = 2 * hstep;
    const unsigned ldsw = (unsigned)wid * 1024u;
    const int aoff = lds_byte(wr * 64 + fr, fq * 8), boff = lds_byte(wc * 32 + fr, fq * 8);
#define PG8_SA(b, h) (((b) * 2 + (h)) * HTB)
#define PG8_SB(b, h) ((4 + (b) * 2 + (h)) * HTB)
#define PG8_STAGE(bufoff, gbase, voff) do { _Pragma("unroll") for (int _i = 0; _i < 2; ++_i) \
        __builtin_amdgcn_global_load_lds((const unsigned*)((const char*)(gbase) + (voff)[_i]), (PG8_LAS unsigned*)(lds + (bufoff) + ldsw + _i * 8192), 16, 0, 0); } while (0)
#define PG8_LDA(dst, b, h) do { _Pragma("unroll") for (int m = 0; m < 4; ++m) _Pragma("unroll") for (int k = 0; k < 2; ++k) dst[m][k] = *(const PG8_LAS bf16x8*)(lds + PG8_SA(b, h) + aoff + m * 2048 + k * 1024); } while (0)
#define PG8_LDB(dst, b, h) do { _Pragma("unroll") for (int n = 0; n < 2; ++n) _Pragma("unroll") for (int k = 0; k < 2; ++k) dst[n][k] = *(const PG8_LAS bf16x8*)(lds + PG8_SB(b, h) + boff + n * 2048 + k * 1024); } while (0)
#define PG8_MMA(ai, bj, At, Bt) do { __builtin_amdgcn_s_setprio(1); _Pragma("unroll") for (int m = 0; m < 4; ++m) _Pragma("unroll") for (int n = 0; n < 2; ++n) _Pragma("unroll") for (int k = 0; k < 2; ++k) \
        acc[ai][bj][m][n] = __builtin_amdgcn_mfma_f32_16x16x32_bf16(Bt[n][k], At[m][k], acc[ai][bj][m][n], 0, 0, 0); __builtin_amdgcn_s_setprio(0); } while (0)
#define PG8_WAIT_V(n) asm volatile("s_waitcnt vmcnt(" #n ")" ::: "memory")
#define PG8_WAIT_L(n) asm volatile("s_waitcnt lgkmcnt(" #n ")" ::: "memory")
#define PG8_BAR __builtin_amdgcn_s_barrier()
#define PG8_SCHED __builtin_amdgcn_sched_barrier(0)
    Unit cur, nxt; int ui = 0;
    if (!S.next(0, cur)) return;
    f32x4 acc[2][2][4][2];
#pragma unroll
    for (int a = 0; a < 2; ++a)
#pragma unroll
        for (int b = 0; b < 2; ++b)
#pragma unroll
            for (int m = 0; m < 4; ++m)
#pragma unroll
                for (int n = 0; n < 2; ++n) acc[a][b][m][n] = (f32x4){0.f, 0.f, 0.f, 0.f};
    bf16x8 At[4][2], B0[2][2], B1[2][2];
    const char* cA = (const char*)g.A + (size_t)cur.pm * tstep; const char* cB = (const char*)g.Bt + (size_t)cur.pn * tstep;
    S.a_ready(cur);
    PG8_STAGE(PG8_SB(0, 0), cB, voffB); PG8_STAGE(PG8_SA(0, 0), cA, voffA); PG8_STAGE(PG8_SB(0, 1), cB + hstep, voffB); PG8_STAGE(PG8_SA(0, 1), cA + hstep, voffA);
    if (wr == 1) PG8_BAR;
    PG8_WAIT_V(4); PG8_BAR;
    PG8_STAGE(PG8_SB(1, 0), cB + kstep, voffB); PG8_STAGE(PG8_SA(1, 0), cA + kstep, voffA); PG8_STAGE(PG8_SB(1, 1), cB + hstep + kstep, voffB);
    PG8_WAIT_V(6); PG8_BAR;
    PG8_STAMP();
    for (;;) {
        const bool has_next = S.next(ui + 1, nxt);
        const char* nA = has_next ? (const char*)g.A + (size_t)nxt.pm * tstep : cA; const char* nB = has_next ? (const char*)g.Bt + (size_t)nxt.pn * tstep : cB;
        for (int t = 0; t < nt; t += 2) {
            const bool last = (t == nt - 2);
            const char* a1 = cA + (size_t)(t + 1) * kstep;
            const char* a2 = last ? nA : cA + (size_t)(t + 2) * kstep; const char* b2 = last ? nB : cB + (size_t)(t + 2) * kstep;
            const char* a3 = a2 + kstep; const char* b3 = b2 + kstep;
            if (last && has_next) S.a_ready(nxt);
            PG8_LDB(B0, 0, 0); PG8_SCHED; PG8_LDA(At, 0, 0); PG8_STAGE(PG8_SA(1, 1), a1 + hstep, voffA);
            PG8_WAIT_L(8); PG8_BAR; PG8_WAIT_L(0); PG8_MMA(0, 0, At, B0); PG8_BAR; PG8_SCHED;
            PG8_LDB(B1, 0, 1); PG8_STAGE(PG8_SB(0, 0), b2, voffB);
            PG8_BAR; PG8_WAIT_L(0); PG8_MMA(0, 1, At, B1); PG8_BAR;
            PG8_LDA(At, 0, 1); PG8_STAGE(PG8_SA(0, 0), a2, voffA);
            PG8_BAR; PG8_WAIT_L(0); PG8_MMA(1, 0, At, B0); PG8_BAR; PG8_SCHED;
            PG8_STAGE(PG8_SB(0, 1), b2 + hstep, voffB);
            PG8_WAIT_V(6); PG8_BAR; PG8_MMA(1, 1, At, B1); PG8_BAR;
            PG8_LDB(B0, 1, 0); PG8_SCHED; PG8_LDA(At, 1, 0); PG8_STAGE(PG8_SA(0, 1), a2 + hstep, voffA);
            PG8_WAIT_L(8); PG8_BAR; PG8_WAIT_L(0); PG8_MMA(0, 0, At, B0); PG8_BAR; PG8_SCHED;
            PG8_LDB(B1, 1, 1); PG8_STAGE(PG8_SB(1, 0), b3, voffB);
            PG8_BAR; PG8_WAIT_L(0); PG8_MMA(0, 1, At, B1); PG8_BAR;
            PG8_LDA(At, 1, 1); PG8_STAGE(PG8_SA(1, 0), a3, voffA);
            PG8_BAR; PG8_WAIT_L(0); PG8_MMA(1, 0, At, B0); PG8_BAR; PG8_SCHED;
            PG8_STAGE(PG8_SB(1, 1), b3 + hstep, voffB);
            PG8_WAIT_V(6); PG8_BAR; PG8_MMA(1, 1, At, B1); PG8_BAR;
        }
        PG8_STAMP();
        if constexpr (!Epi::AFTER_DRAIN) { E(acc, cur, wr, wc, fr, fq); S.done(cur); }
        PG8_STAMP();
        if (!has_next) break;
#pragma unroll
        for (int a = 0; a < 2; ++a)
#pragma unroll
            for (int b = 0; b < 2; ++b)
#pragma unroll
                for (int m = 0; m < 4; ++m)
#pragma unroll
                    for (int n = 0; n < 2; ++n) acc[a][b][m][n] = (f32x4){0.f, 0.f, 0.f, 0.f};
        cur = nxt; cA = nA; cB = nB; ++ui;
    }
    PG8_WAIT_V(0);
    if (wr == 0) PG8_BAR;
    PG8_BAR;
    if constexpr (Epi::AFTER_DRAIN) { E.fused(acc, cur, wr, wc, fr, fq, lds, wid, lane); S.done(cur); }
    PG8_STAMP();
    if (STAMP && wid == 0) { stamps[lane] = lane < nts ? (((unsigned long long)(unsigned)ts_hi << 32) | (unsigned)ts_lo) : 0ull;
        if (lane == 62) stamps[62] = rt_entry; if (lane == 63) stamps[63] = (unsigned long long)wall_clock64(); }
#undef PG8_STAMP
#undef PG8_SA
#undef PG8_SB
#undef PG8_STAGE
#undef PG8_LDA
#undef PG8_LDB
#undef PG8_MMA
#undef PG8_WAIT_V
#undef PG8_WAIT_L
#undef PG8_BAR
#undef PG8_SCHED
}
}

using pg8::bf16_t; using pg8::bf16x8; using pg8::f32x4; using pg8::u32x4;
typedef short s16x4 __attribute__((ext_vector_type(4)));
typedef unsigned u32x2 __attribute__((ext_vector_type(2)));
#define DI __device__ __forceinline__
#define LAUNDER(ptr) asm volatile("" : "+s"(ptr))

constexpr int T_TOK = 32768, SEQ = 16384, DM = 1024;
constexpr int LDS_BYTES = 131072 + 256;
constexpr size_t MiB = 1ull << 20;
constexpr size_t W_IN0 = 0, W_OUT0 = 10 * MiB, W_UP0 = 13 * MiB, W_DN0 = 21 * MiB, W_IN1 = 29 * MiB, W_OUT1 = 35 * MiB, W_UP1 = 37 * MiB, W_DN1 = 45 * MiB;
constexpr size_t O_G32 = 53 * MiB, O_HGDEC = 54 * MiB, O_NLOC = 55 * MiB, O_NPREV = 56 * MiB, O_SCAL = 57 * MiB;
constexpr size_t O_P16_L0 = 58 * MiB, O_ST_L0 = 378 * MiB, O_H16A = 378 * MiB;
constexpr size_t O_Z32 = 58 * MiB, O_H16B = 186 * MiB, O_U16 = 250 * MiB;
constexpr size_t O_P16_L1 = 250 * MiB, O_ST_L1 = 58 * MiB, O_Y16_L1 = 442 * MiB;
constexpr size_t O_BAR = 57 * MiB + 65536;
constexpr size_t WS_NEED = 506 * MiB;

constexpr size_t SLS = (size_t)T_TOK * 128;
struct Params {
    const float *x, *norm_g, *hg_lb, *ev_w_in, *ev_hg_g, *ev_ret_g, *ev_w_out, *od_w_in, *od_conv_w, *od_conv_b, *od_gate_b, *od_ml_g, *od_w_out, *mlp_w1, *mlp_w2;
    float* out; unsigned char* ws; int phase_lo, phase_hi;
};

extern __shared__ __attribute__((aligned(16))) unsigned char smem[];

DI float bf2f(bf16_t b) { return __uint_as_float(((unsigned)b) << 16); }
typedef float f32x2_t __attribute__((ext_vector_type(2)));
typedef __bf16 bf16x2_t __attribute__((ext_vector_type(2)));
DI unsigned pk2(float lo, float hi) { const f32x2_t v = {lo, hi}; return __builtin_bit_cast(unsigned, __builtin_convertvector(v, bf16x2_t)); }
DI bf16_t f2bf(float f) { return (bf16_t)(pk2(f, f) & 0xffffu); }
DI float lo16(unsigned u) { return __uint_as_float(u << 16); }
DI float hi16(unsigned u) { return __uint_as_float(u & 0xffff0000u); }
DI float rdlane_(float v, int l) { return __builtin_bit_cast(float, __builtin_amdgcn_readlane(__builtin_bit_cast(int, v), l)); }
DI float row16_sum(float v);
DI float wave_sum(float v) { v = row16_sum(v); return (rdlane_(v, 0) + rdlane_(v, 16)) + (rdlane_(v, 32) + rdlane_(v, 48)); }
DI void lds_barrier() { __builtin_amdgcn_sched_barrier(0); asm volatile("s_waitcnt lgkmcnt(0)\n\ts_barrier" ::: "memory"); __builtin_amdgcn_sched_barrier(0); }
DI float tanh_fast(float x) { const float e = __expf(2.f * x); return (e - 1.f) * __builtin_amdgcn_rcpf(e + 1.f); }
DI float log1p_fast(float u) { const float ser = u * (1.f + u * (-0.5f + u * (0.33333333f + u * (-0.25f + u * (0.2f + u * (-0.16666667f + u * 0.14285714f)))))); return (u < 0.06f) ? ser : __logf(1.f + u); }
#define DPPF(OLD, V, CTRL, RMASK) __builtin_bit_cast(float, __builtin_amdgcn_update_dpp(__builtin_bit_cast(int, (float)(OLD)), __builtin_bit_cast(int, (float)(V)), (CTRL), (RMASK), 0xf, false))
DI float rdlane(float v, int l) { return __builtin_bit_cast(float, __builtin_amdgcn_readlane(__builtin_bit_cast(int, v), l)); }
DI float wave_scan_sum(float v) {
    v += DPPF(0.f, v, 0x111, 0xf); v += DPPF(0.f, v, 0x112, 0xf); v += DPPF(0.f, v, 0x114, 0xf); v += DPPF(0.f, v, 0x118, 0xf);
    v += DPPF(0.f, v, 0x142, 0xa); v += DPPF(0.f, v, 0x143, 0xc);
    return v;
}
DI float wave_scan_max(float v) {
    const float ninf = -__builtin_inff();
    v = fmaxf(v, DPPF(ninf, v, 0x111, 0xf)); v = fmaxf(v, DPPF(ninf, v, 0x112, 0xf)); v = fmaxf(v, DPPF(ninf, v, 0x114, 0xf)); v = fmaxf(v, DPPF(ninf, v, 0x118, 0xf));
    v = fmaxf(v, DPPF(ninf, v, 0x142, 0xa)); v = fmaxf(v, DPPF(ninf, v, 0x143, 0xc));
    return v;
}
DI float row16_sum(float v) {
    v += __builtin_bit_cast(float, __builtin_amdgcn_update_dpp(0, __builtin_bit_cast(int, v), 0x121, 0xf, 0xf, false));
    v += __builtin_bit_cast(float, __builtin_amdgcn_update_dpp(0, __builtin_bit_cast(int, v), 0x122, 0xf, 0xf, false));
    v += __builtin_bit_cast(float, __builtin_amdgcn_update_dpp(0, __builtin_bit_cast(int, v), 0x124, 0xf, 0xf, false));
    v += __builtin_bit_cast(float, __builtin_amdgcn_update_dpp(0, __builtin_bit_cast(int, v), 0x128, 0xf, 0xf, false));
    return v;
}
DI float siluf(float x) { return x * __builtin_amdgcn_rcpf(1.f + __expf(-x)); }
DI float sigmf(float x) { return __builtin_amdgcn_rcpf(1.f + __expf(-x)); }

struct EpiBf {
    static constexpr bool PERM = true, AFTER_DRAIN = false;
    bf16_t* O; int ldc; int relu2; int sl;
    __device__ __forceinline__ void operator()(const f32x4 (&acc)[2][2][4][2], const pg8::Unit& u, int wr, int wc, int fr, int fq) const {
        const int row0 = u.pm * 256 + wr * 64 + fr, col0 = u.pn * 256 + wc * 32 + 8 * fq;
#pragma unroll
        for (int ai = 0; ai < 2; ++ai)
#pragma unroll
            for (int m = 0; m < 4; ++m) { const int row = row0 + ai * 128 + m * 16;
                bf16_t* rowp = sl ? (O + (size_t)(col0 >> 7) * SLS + (size_t)row * 128 + (col0 & 127)) : (O + (size_t)row * ldc + col0);
                const size_t bjstep = sl ? SLS : (size_t)128;
#pragma unroll
                for (int bj = 0; bj < 2; ++bj) { f32x4 v0 = acc[ai][bj][m][0], v1 = acc[ai][bj][m][1];
                    if (relu2) {
#pragma unroll
                        for (int j = 0; j < 4; ++j) { float a = fmaxf(v0[j], 0.f), b = fmaxf(v1[j], 0.f); v0[j] = a * a; v1[j] = b * b; } }
                    u32x4 w; w.x = pk2(v0[0], v0[1]); w.y = pk2(v0[2], v0[3]); w.z = pk2(v1[0], v1[1]); w.w = pk2(v1[2], v1[3]);
                    *(u32x4*)(rowp + bj * bjstep) = w; } }
    }
};

DI void run_gemm(const Params& p, int ph) {
    const bf16_t* A; const bf16_t* Bt; int N, K, kind; void* out;
    unsigned char* ws = p.ws;
    switch (ph) {
        case 1:  A = (const bf16_t*)(ws + O_H16A); Bt = (const bf16_t*)(ws + W_IN0); N = 5120; K = 1024; kind = 0; out = ws + O_P16_L0; break;
        case 8:  A = (const bf16_t*)p.out;          Bt = (const bf16_t*)(ws + W_OUT0); N = 1024; K = 1536; kind = 0; out = ws + O_Z32; break;
        case 10: A = (const bf16_t*)(ws + O_H16B); Bt = (const bf16_t*)(ws + W_UP0); N = 4096; K = 1024; kind = 1; out = ws + O_U16; break;
        case 11: A = (const bf16_t*)(ws + O_U16);  Bt = (const bf16_t*)(ws + W_DN0); N = 1024; K = 4096; kind = 0; out = ws + O_Z32; break;
        case 13: A = (const bf16_t*)(ws + O_H16B); Bt = (const bf16_t*)(ws + W_IN1); N = 3072; K = 1024; kind = 0; out = ws + O_P16_L1; break;
        case 17: A = (const bf16_t*)(ws + O_Y16_L1); Bt = (const bf16_t*)(ws + W_OUT1); N = 1024; K = 1024; kind = 0; out = ws + O_Z32; break;
        case 19: A = (const bf16_t*)(ws + O_H16B); Bt = (const bf16_t*)(ws + W_UP1); N = 4096; K = 1024; kind = 1; out = ws + O_U16; break;
        default: A = (const bf16_t*)(ws + O_U16);  Bt = (const bf16_t*)(ws + W_DN1); N = 1024; K = 4096; kind = 0; out = ws + O_Z32; break;
    }
    pg8::Gemm g; g.A = A; g.Bt = Bt; g.M = T_TOK; g.N = N; g.K = K;
    pg8::StaticOrder S; S.init(T_TOK, N, (int)gridDim.x, (int)blockIdx.x);
    if (kind == 2) { pg8::EpiF32 e; e.C = (float*)out; e.ldc = N; e.bias = nullptr; pg8::gemm_phase<pg8::EpiF32, pg8::StaticOrder, false>((PG8_LAS unsigned char*)smem, g, S, e, nullptr); }
    else { EpiBf e; e.O = (bf16_t*)out; e.ldc = N; e.relu2 = kind; e.sl = (ph == 1 || ph == 13) ? 1 : 0; pg8::gemm_phase<EpiBf, pg8::StaticOrder, false>((PG8_LAS unsigned char*)smem, g, S, e, nullptr); }
}

struct TileDesc { const float* W; bf16_t* Wt; int ldw, K, k0, n0; };
DI void load_row(const float* src, int lane, f32x4 (&v)[4]) {
#pragma unroll
    for (int i = 0; i < 4; ++i) v[i] = *(const f32x4*)(src + lane * 4 + i * 256);
}
DI void load_row_nt(const float* src, int lane, f32x4 (&v)[4]) {
#pragma unroll
    for (int i = 0; i < 4; ++i) v[i] = __builtin_nontemporal_load((const f32x4*)(src + lane * 4 + i * 256));
}
DI float row_ss(const f32x4 (&v)[4]) {
    float s = 0.f;
#pragma unroll
    for (int i = 0; i < 4; ++i) s += v[i][0] * v[i][0] + v[i][1] * v[i][1] + v[i][2] * v[i][2] + v[i][3] * v[i][3];
    return wave_sum(s);
}

template <int MODE, bool GATES>
DI void row_phase(const bf16_t* z, const float* xin, float* xo, const float* ga, const float* gb, bf16_t* hdst, const float* wg_src, float* g32) {
    const int tid = ltid(), lane = tid & 63, wid = tid >> 6;
    float* wgl = (float*)smem;
    if (GATES) {
        for (int idx = tid; idx < 1024 * 8; idx += 512) { const int k = idx >> 3, j = idx & 7; wgl[idx] = wg_src[(size_t)k * 3080 + 3072 + j]; }
        __syncthreads();
    }
    f32x4 gav[4], gbv[4];
    load_row(ga, lane, gav);
    if (MODE == 1) load_row(gb, lane, gbv);
    f32x4 xn[4]; u32x2 zn[4];
    const int rstride = gridDim.x * 8;
    int row = blockIdx.x * 8 + wid;
    if (row < T_TOK) { load_row_nt(xin + (size_t)row * DM, lane, xn);
        if (MODE != 0) {
#pragma unroll
            for (int i = 0; i < 4; ++i) zn[i] = __builtin_nontemporal_load((const u32x2*)(z + (size_t)row * DM + lane * 4 + i * 256)); } }
    for (; row < T_TOK; row += rstride) {
        f32x4 xv[4], hv[4]; u32x2 zr[4];
#pragma unroll
        for (int i = 0; i < 4; ++i) { xv[i] = xn[i]; if (MODE != 0) zr[i] = zn[i]; }
        { const int nrow = row + rstride;
          if (nrow < T_TOK) { load_row_nt(xin + (size_t)nrow * DM, lane, xn);
            if (MODE != 0) {
#pragma unroll
                for (int i = 0; i < 4; ++i) zn[i] = __builtin_nontemporal_load((const u32x2*)(z + (size_t)nrow * DM + lane * 4 + i * 256)); } } }
        if (MODE == 0) {
            const float r = rsqrtf(row_ss(xv) * (1.f / 1024.f) + 1e-6f);
#pragma unroll
            for (int i = 0; i < 4; ++i) hv[i] = xv[i] * r * gav[i];
        } else {
            f32x4 zv[4];
#pragma unroll
            for (int i = 0; i < 4; ++i) zv[i] = (f32x4){lo16(zr[i].x), hi16(zr[i].x), lo16(zr[i].y), hi16(zr[i].y)};
            const float rz = rsqrtf(row_ss(zv) * (1.f / 1024.f) + 1e-6f);
#pragma unroll
            for (int i = 0; i < 4; ++i) { xv[i] = xv[i] + zv[i] * rz * gav[i]; __builtin_nontemporal_store(xv[i], (f32x4*)(xo + (size_t)row * DM + lane * 4 + i * 256)); }
            if (MODE == 1) {
                const float r = rsqrtf(row_ss(xv) * (1.f / 1024.f) + 1e-6f);
#pragma unroll
                for (int i = 0; i < 4; ++i) hv[i] = xv[i] * r * gbv[i];
            }
        }
        if (MODE != 2) {
#pragma unroll
            for (int i = 0; i < 4; ++i) { u32x2 w; w.x = pk2(hv[i][0], hv[i][1]); w.y = pk2(hv[i][2], hv[i][3]); *(u32x2*)(hdst + (size_t)row * DM + lane * 4 + i * 256) = w; }
        }
        if (GATES) {
            float gsum[8];
#pragma unroll
            for (int j = 0; j < 8; ++j) gsum[j] = 0.f;
#pragma unroll
            for (int i = 0; i < 4; ++i)
#pragma unroll
                for (int e = 0; e < 4; ++e) { const int k = lane * 4 + i * 256 + e; const f32x4 w0 = *(const f32x4*)(wgl + k * 8), w1 = *(const f32x4*)(wgl + k * 8 + 4); const float hvv = hv[i][e];
                    gsum[0] += hvv * w0[0]; gsum[1] += hvv * w0[1]; gsum[2] += hvv * w0[2]; gsum[3] += hvv * w0[3];
                    gsum[4] += hvv * w1[0]; gsum[5] += hvv * w1[1]; gsum[6] += hvv * w1[2]; gsum[7] += hvv * w1[3];
                    __builtin_amdgcn_sched_barrier(0); }
#pragma unroll
            for (int j = 0; j < 8; ++j) gsum[j] = wave_sum(gsum[j]);
            if (lane == 0) { f32x4 a = {gsum[0], gsum[1], gsum[2], gsum[3]}, b = {gsum[4], gsum[5], gsum[6], gsum[7]}; *(f32x4*)(g32 + (size_t)row * 8) = a; *(f32x4*)(g32 + (size_t)row * 8 + 4) = b; }
        }
    }
}

DI TileDesc prep_tile(const Params& p, int t) {
    unsigned char* ws = p.ws;
    const int nt0 = 16 * 80, nt1 = nt0 + 24 * 16, nt2 = nt1 + 16 * 64, nt3 = nt2 + 64 * 16, nt4 = nt3 + 16 * 48, nt5 = nt4 + 16 * 16, nt6 = nt5 + 16 * 64;
    const float* W; int ldw, K, NT, local; bf16_t* Wt;
    if (t < nt0)      { W = p.ev_w_in;  ldw = 5120; K = 1024; NT = 80; Wt = (bf16_t*)(ws + W_IN0);  local = t; }
    else if (t < nt1) { W = p.ev_w_out; ldw = 1024; K = 1536; NT = 16; Wt = (bf16_t*)(ws + W_OUT0); local = t - nt0; }
    else if (t < nt2) { W = p.mlp_w1;   ldw = 4096; K = 1024; NT = 64; Wt = (bf16_t*)(ws + W_UP0);  local = t - nt1; }
    else if (t < nt3) { W = p.mlp_w2;   ldw = 1024; K = 4096; NT = 16; Wt = (bf16_t*)(ws + W_DN0);  local = t - nt2; }
    else if (t < nt4) { W = p.od_w_in;  ldw = 3080; K = 1024; NT = 48; Wt = (bf16_t*)(ws + W_IN1);  local = t - nt3; }
    else if (t < nt5) { W = p.od_w_out; ldw = 1024; K = 1024; NT = 16; Wt = (bf16_t*)(ws + W_OUT1); local = t - nt4; }
    else if (t < nt6) { W = p.mlp_w1 + (size_t)1024 * 4096; ldw = 4096; K = 1024; NT = 64; Wt = (bf16_t*)(ws + W_UP1); local = t - nt5; }
    else              { W = p.mlp_w2 + (size_t)4096 * 1024; ldw = 1024; K = 4096; NT = 16; Wt = (bf16_t*)(ws + W_DN1); local = t - nt6; }
    TileDesc d; d.W = W; d.Wt = Wt; d.ldw = ldw; d.K = K; d.k0 = (local / NT) * 64; d.n0 = (local % NT) * 64; return d;
}
DI void prep_phase(const Params& p) {
    unsigned char* ws = p.ws;
    const int NTILES = 16 * 80 + 24 * 16 + 16 * 64 + 64 * 16 + 16 * 48 + 16 * 16 + 16 * 64 + 64 * 16;
    float* tl = (float*)smem;
    const int tid = ltid();
    f32x4 rv[2];
    int t = blockIdx.x;
    TileDesc cur = prep_tile(p, t < NTILES ? t : 0);
    if (t < NTILES) {
#pragma unroll
        for (int i = 0; i < 2; ++i) { const int idx = tid + i * 512, kk = idx >> 4, n4 = (idx & 15) * 4; rv[i] = __builtin_nontemporal_load((const f32x4*)(cur.W + (size_t)(cur.k0 + kk) * cur.ldw + cur.n0 + n4)); }
    }
    for (; t < NTILES; t += gridDim.x) {
#pragma unroll
        for (int i = 0; i < 2; ++i) { const int idx = tid + i * 512, kk = idx >> 4, n4 = (idx & 15) * 4;
            tl[kk * 65 + n4] = rv[i][0]; tl[kk * 65 + n4 + 1] = rv[i][1]; tl[kk * 65 + n4 + 2] = rv[i][2]; tl[kk * 65 + n4 + 3] = rv[i][3]; }
        lds_barrier();
        const int tn = t + gridDim.x;
        TileDesc nxt = prep_tile(p, tn < NTILES ? tn : 0);
        if (tn < NTILES) {
#pragma unroll
            for (int i = 0; i < 2; ++i) { const int idx = tid + i * 512, kk = idx >> 4, n4 = (idx & 15) * 4; rv[i] = __builtin_nontemporal_load((const f32x4*)(nxt.W + (size_t)(nxt.k0 + kk) * nxt.ldw + nxt.n0 + n4)); }
        }
        { const int nn = tid >> 3, k8 = (tid & 7) * 8; u32x4 w;
          w.x = pk2(tl[(k8 + 0) * 65 + nn], tl[(k8 + 1) * 65 + nn]); w.y = pk2(tl[(k8 + 2) * 65 + nn], tl[(k8 + 3) * 65 + nn]);
          w.z = pk2(tl[(k8 + 4) * 65 + nn], tl[(k8 + 5) * 65 + nn]); w.w = pk2(tl[(k8 + 6) * 65 + nn], tl[(k8 + 7) * 65 + nn]);
          *(u32x4*)(cur.Wt + (size_t)(cur.n0 + nn) * cur.K + cur.k0 + k8) = w; }
        lds_barrier();
        cur = nxt;
    }
    row_phase<0, false>(nullptr, p.x, nullptr, p.norm_g, nullptr, (bf16_t*)(ws + O_H16A), nullptr, nullptr);
}

constexpr int QS = 136, PS = 72;
constexpr int L_QE = 0, L_KE = 17408, L_VV = 34816, L_PP = 68608, L_SM = 77824, L_CW = 90112;
constexpr int SM_ALPHA = 0, SM_BETA = 256, SM_WROW = 512, SM_DEN = 768, SM_SS = 1024, SM_EMR = 1280, SM_INVF = 1536, SM_SEG = 2048, SM_NPR = 4096, SM_GN = 4608, SM_GB = 5632;

DI bf16x8 trfrag(const bf16_t* img, int rs, int s0, int c0, int lane) {
    const int g = lane >> 4, q = (lane & 15) >> 2, pp = lane & 3;
    const bf16_t* a = img + (s0 + g * 8 + q) * rs + c0 + 4 * pp;
    const s16x4 lo = __builtin_amdgcn_ds_read_tr16_b64_v4i16((LAS s16x4*)a);
    const s16x4 hi = __builtin_amdgcn_ds_read_tr16_b64_v4i16((LAS s16x4*)(a + 4 * rs));
    return __builtin_shufflevector(lo, hi, 0, 1, 2, 3, 4, 5, 6, 7);
}
#define MFMA16(a, b, c) __builtin_amdgcn_mfma_f32_16x16x32_bf16((a), (b), (c), 0, 0, 0)

#define SLA(base, row, col) ((base) + (size_t)((col) >> 7) * SLS + (size_t)(row) * 128 + ((col) & 127))
template <int MIX> struct MixC { static constexpr int DV = (MIX == 0) ? 128 : 256; };

template <int MIX, bool PASS3>
DI void chunk_phase(const Params& p) {
    constexpr int DV = MixC<MIX>::DV, VS = DV + 8, NT = DV / 128, EPC = DV * 128, OS = DV + 4;
    constexpr int NVL = DV / 64;
    constexpr bool VPRE = true;
    constexpr int gcol0 = (MIX == 0) ? 1536 : (MIX == 1) ? 4096 : 2048;
    constexpr int VPR = DV / 8, NJ = (64 * VPR) / 512;
    constexpr int vcol0 = (MIX == 0) ? 1024 : (MIX == 1) ? 3072 : 1024;
    int tid = ltid(), lane = tid & 63, wid = tid >> 6, fr = lane & 15, fq = lane >> 4;
    const int G = gridDim.x;
    unsigned char* ws = p.ws;
    bf16_t* QE = (bf16_t*)(smem + L_QE); bf16_t* KE = (bf16_t*)(smem + L_KE); bf16_t* VV = (bf16_t*)(smem + L_VV); bf16_t* PP = (bf16_t*)(smem + L_PP);
    float* alpha = (float*)(smem + L_SM + SM_ALPHA); float* beta = (float*)(smem + L_SM + SM_BETA); float* wrow = (float*)(smem + L_SM + SM_WROW);
    float* den = (float*)(smem + L_SM + SM_DEN); float* ssq = (float*)(smem + L_SM + SM_SS); float* emr = (float*)(smem + L_SM + SM_EMR);
    float* invf = (float*)(smem + L_SM + SM_INVF); float* segsum = (float*)(smem + L_SM + SM_SEG); float* nprl = (float*)(smem + L_SM + SM_NPR); float* gnl = (float*)(smem + L_SM + SM_GN); float* gbl = (float*)(smem + L_SM + SM_GB);
    float* OL = (float*)smem;
    const bf16_t* P16 = (const bf16_t*)(ws + (MIX == 2 ? O_P16_L1 : O_P16_L0));
    constexpr int LDP = (MIX == 2) ? 3072 : 5120;
    bf16_t* ST = (bf16_t*)(ws + (MIX == 2 ? O_ST_L1 : O_ST_L0));
    bf16_t* Y16 = (MIX == 2) ? (bf16_t*)(ws + O_Y16_L1) : (bf16_t*)p.out;
    constexpr int LDY = (MIX == 2) ? 1024 : 1536;
    float* G32 = (float*)(ws + O_G32); float* HGDEC = (float*)(ws + O_HGDEC); float* NLOC = (float*)(ws + O_NLOC); float* NPREV = (float*)(ws + O_NPREV);
    float* BLAST = (float*)(ws + O_SCAL); float* MLOC = BLAST + 2048; float* MPREV = BLAST + 4096;
    bf16_t* QKC = (bf16_t*)(ws + O_H16B);
    int v0 = wid * (DV / 8);

    if (MIX == 1) { if (tid < 64) invf[tid] = powf(10000.f, -(float)tid / 64.f); }
    if (PASS3) { const float* gn = (MIX == 0) ? p.ev_hg_g : (MIX == 1) ? p.ev_ret_g : p.od_ml_g; if (tid < DV) gnl[tid] = gn[tid]; }
    if (MIX == 2) { if (tid < 8) gbl[tid] = p.od_gate_b[tid]; }
    float* cwl = (float*)(smem + L_CW);
    if (MIX == 2 && !PASS3) {
        for (int i = tid; i < 4096; i += 512) cwl[i] = p.od_conv_w[i];
        for (int i = tid; i < 1024; i += 512) cwl[4096 + i] = p.od_conv_b[i];
    }
    __syncthreads();

    bf16x8 sbn[NT][4]; u32x4 gtn[NJ]; u32x4 vld[NVL];
    bf16_t hfr[16], hqr[16]; float rf0 = 0.f, rf1 = 0.f, rf2 = 0.f, rf3 = 0.f;
    u32x4 cr[7];
    u32x4 ra0, ra1, ra2, ra3;

    auto issue_sb = [&](int it) {
        const bf16_t* STi = ST + (size_t)it * EPC;
#pragma unroll
        for (int n = 0; n < NT; ++n)
#pragma unroll
            for (int kk = 0; kk < 4; ++kk) sbn[n][kk] = __builtin_nontemporal_load((const bf16x8*)(STi + ((((wid * NT + n) * 4 + kk) * 64 + lane) << 3)));
    };
    auto issue_gt = [&](int it) {
        const int c = it & 255, bh = it >> 8, b = bh >> 2, h = bh & 3;
        const int r0 = b * SEQ + c * 64;
#pragma unroll
        for (int j = 0; j < NJ; ++j) { const int idx = tid + j * 512, t = (idx >> 4) & 63, v8 = (idx >> 10) * 128 + (idx & 15) * 8;
            gtn[j] = __builtin_nontemporal_load((const u32x4*)SLA(P16, r0 + t, gcol0 + h * DV + v8)); }
    };
    auto issue = [&](int it) {
        const int c = it & 255, bh = it >> 8, b = bh >> 2, h = bh & 3;
        const int r0 = b * SEQ + c * 64;
        if (VPRE) {
#pragma unroll
            for (int j = 0; j < NVL; ++j) { const int idx = tid + j * 512, t = (idx >> 4) & 63, v8 = (idx >> 10) * 128 + (idx & 15) * 8;
                vld[j] = __builtin_nontemporal_load((const u32x4*)SLA(P16, r0 + t, vcol0 + h * DV + v8)); }
        }
        if (MIX == 0) {
            const int d = tid & 127, seg = tid >> 7, hd = h * 128 + d;
            rf0 = p.hg_lb[hd]; rf1 = p.hg_lb[512 + hd]; rf2 = p.hg_lb[1024 + hd];
            const bf16_t* basef = SLA(P16, r0 + seg * 16, 512 + hd); const bf16_t* baseq = SLA(P16, r0 + seg * 16, hd);
#pragma unroll
            for (int i = 0; i < 16; ++i) { hfr[i] = __builtin_nontemporal_load(basef + i * 128); if (PASS3) hqr[i] = __builtin_nontemporal_load(baseq + i * 128); }
        } else if (MIX == 1) {
            const int t = tid >> 3, i0 = (tid & 7) * 8;
            ra0 = __builtin_nontemporal_load((const u32x4*)SLA(P16, r0 + t, 2560 + h * 128 + i0)); ra1 = __builtin_nontemporal_load((const u32x4*)SLA(P16, r0 + t, 2560 + h * 128 + 64 + i0));
            if (PASS3) { ra2 = __builtin_nontemporal_load((const u32x4*)SLA(P16, r0 + t, 2048 + h * 128 + i0)); ra3 = __builtin_nontemporal_load((const u32x4*)SLA(P16, r0 + t, 2048 + h * 128 + 64 + i0)); }
        } else {
            const int r = r0 + lane;
            rf0 = G32[(size_t)r * 8 + h]; rf1 = G32[(size_t)r * 8 + 4 + h];
            if (!PASS3) {
                const int cg = tid & 31, t0 = (tid >> 5) * 4, col = (cg >> 4) * 512 + h * 128 + (cg & 15) * 8;
#pragma unroll
                for (int i = 0; i < 7; ++i) { const int tok = c * 64 + t0 - 3 + i;
                    cr[i] = (u32x4){0u, 0u, 0u, 0u};
                    if (tok >= 0) cr[i] = *(const u32x4*)SLA(P16, b * SEQ + tok, col); }
            }
            if (PASS3) {
                rf2 = MPREV[it]; if (tid < 128) rf3 = NPREV[(size_t)it * 128 + tid];
                { const int tt = tid >> 4, c8 = (tid & 15) * 8; ra0 = __builtin_nontemporal_load((const u32x4*)SLA(QKC, r0 + tt, h * 128 + c8)); ra2 = __builtin_nontemporal_load((const u32x4*)SLA(QKC, r0 + tt, 512 + h * 128 + c8)); }
                { const int tt = (tid + 512) >> 4, c8 = (tid & 15) * 8; ra1 = __builtin_nontemporal_load((const u32x4*)SLA(QKC, r0 + tt, h * 128 + c8)); ra3 = __builtin_nontemporal_load((const u32x4*)SLA(QKC, r0 + tt, 512 + h * 128 + c8)); }
            }
        }
    };

    auto transform = [&](int it) {
        const int c = it & 255, bh = it >> 8, b = bh >> 2, h = bh & 3;
        const int r0 = b * SEQ + c * 64;
        if (MIX == 0) {
            const int d = tid & 127, seg = tid >> 7;
            const float mx = fmaxf(rf0, fmaxf(rf1, rf2)); const float e0 = __expf(rf0 - mx), e1 = __expf(rf1 - mx), e2 = __expf(rf2 - mx);
            const float lb = e0 * __builtin_amdgcn_rcpf(e0 + e1 + e2);
            float pc[16], kk_[16]; float run = 1.f;
#pragma unroll
            for (int i = 0; i < 16; ++i) { const float xf = bf2f(hfr[i]); const float f = lb + (1.f - lb) * sigmf(xf); run *= f; pc[i] = run; kk_[i] = 1.f - f; }
            segsum[seg * 128 + d] = run;
            lds_barrier();
            float off = 1.f, tot = 1.f;
#pragma unroll
            for (int s2 = 0; s2 < 4; ++s2) { const float v = segsum[s2 * 128 + d]; tot *= v; if (s2 < seg) off *= v; }
#pragma unroll
            for (int i = 0; i < 16; ++i) { const float pb = off * pc[i]; const int t = seg * 16 + i;
                const float rpb = __builtin_amdgcn_rcpf(fmaxf(pb, 1e-35f));
                if (PASS3) { const float q = siluf(bf2f(hqr[i]));
                    QE[t * QS + d] = f2bf(q * pb); KE[t * QS + d] = f2bf(kk_[i] * rpb); }
                else KE[t * QS + d] = f2bf(kk_[i] * tot * rpb); }
            if (!PASS3 && seg == 0) HGDEC[(size_t)it * 128 + d] = tot;
        } else if (MIX == 1) {
            const float lg = log1pf(-exp2f(-5.f - (float)h));
            const int t = tid >> 3, i0 = (tid & 7) * 8, pos = c * 64 + t;
            const u32x4 k1 = ra0, k2 = ra1, q1 = PASS3 ? ra2 : ra0, q2 = PASS3 ? ra3 : ra1;
            const float ksc = 0.08838834764831845f * (PASS3 ? 1.f : __expf(lg * (float)(63 - t)));
            u32x4 qa, qb, ka, kb;
#pragma unroll
            for (int jj = 0; jj < 4; ++jj) {
                float cs[2], sn[2];
#pragma unroll
                for (int e = 0; e < 2; ++e) { double rev = (double)pos * (double)invf[i0 + jj * 2 + e] * 0.15915494309189535; rev -= rint(rev); const float frc = (float)rev;
                    sn[e] = __builtin_amdgcn_sinf(frc); cs[e] = __builtin_amdgcn_cosf(frc); }
                { const float x1l = lo16(k1[jj]), x1h = hi16(k1[jj]), x2l = lo16(k2[jj]), x2h = hi16(k2[jj]);
                  ka[jj] = pk2((x1l * cs[0] - x2l * sn[0]) * ksc, (x1h * cs[1] - x2h * sn[1]) * ksc);
                  kb[jj] = pk2((x2l * cs[0] + x1l * sn[0]) * ksc, (x2h * cs[1] + x1h * sn[1]) * ksc); }
                if (PASS3) { const float x1l = lo16(q1[jj]), x1h = hi16(q1[jj]), x2l = lo16(q2[jj]), x2h = hi16(q2[jj]);
                  qa[jj] = pk2(x1l * cs[0] - x2l * sn[0], x1h * cs[1] - x2h * sn[1]);
                  qb[jj] = pk2(x2l * cs[0] + x1l * sn[0], x2h * cs[1] + x1h * sn[1]); }
            }
            *(u32x4*)(KE + t * QS + i0) = ka; *(u32x4*)(KE + t * QS + 64 + i0) = kb;
            if (PASS3) { *(u32x4*)(QE + t * QS + i0) = qa; *(u32x4*)(QE + t * QS + 64 + i0) = qb; }
            if (PASS3 && tid < 64) { alpha[tid] = lg * (float)tid; beta[tid] = -lg * (float)tid; wrow[tid] = __expf(lg * (float)(tid + 1)); }
        } else {
            const float igp = rf0 + gbl[h], fgp = rf1 + gbl[4 + h];
            const float ig = 15.f * tanh_fast(igp * (1.f / 15.f)); const float fc = 15.f * tanh_fast(fgp * (1.f / 15.f));
            const float lf = -log1p_fast(__expf(-fc));
            const float bc = wave_scan_sum(lf);
            const float blast = rdlane(bc, 63);
            if (!PASS3) {
                const float lwe = blast - bc + ig; const float ml = rdlane(wave_scan_max(lwe), 63);
                const float ksc = expf(lwe - ml);
                if (tid == 0) { BLAST[it] = blast; MLOC[it] = ml; }
                {
                    const int cg = tid & 31, t0 = (tid >> 5) * 4, which = cg >> 4, c8 = (cg & 15) * 8, col = which * 512 + h * 128 + c8;
                    float wv[4][8], bv[8];
#pragma unroll
                    for (int jj = 0; jj < 4; ++jj) { const f32x4 w0 = *(const f32x4*)(cwl + jj * 1024 + col), w1 = *(const f32x4*)(cwl + jj * 1024 + col + 4);
                        wv[jj][0] = w0[0]; wv[jj][1] = w0[1]; wv[jj][2] = w0[2]; wv[jj][3] = w0[3]; wv[jj][4] = w1[0]; wv[jj][5] = w1[1]; wv[jj][6] = w1[2]; wv[jj][7] = w1[3]; }
                    { const f32x4 b0 = *(const f32x4*)(cwl + 4096 + col), b1 = *(const f32x4*)(cwl + 4096 + col + 4);
                      bv[0] = b0[0]; bv[1] = b0[1]; bv[2] = b0[2]; bv[3] = b0[3]; bv[4] = b1[0]; bv[5] = b1[1]; bv[6] = b1[2]; bv[7] = b1[3]; }
                    const float sc = (which == 1) ? 0.08838834764831845f : 1.f;
#pragma unroll
                    for (int i = 0; i < 4; ++i) {
                        const int t = t0 + i;
                        float acc[8];
#pragma unroll
                        for (int e = 0; e < 8; ++e) acc[e] = bv[e];
#pragma unroll
                        for (int jj = 0; jj < 4; ++jj) { const u32x4 xv = cr[i + jj];
                            acc[0] += wv[jj][0] * lo16(xv[0]); acc[1] += wv[jj][1] * hi16(xv[0]); acc[2] += wv[jj][2] * lo16(xv[1]); acc[3] += wv[jj][3] * hi16(xv[1]);
                            acc[4] += wv[jj][4] * lo16(xv[2]); acc[5] += wv[jj][5] * hi16(xv[2]); acc[6] += wv[jj][6] * lo16(xv[3]); acc[7] += wv[jj][7] * hi16(xv[3]); }
#pragma unroll
                        for (int e = 0; e < 8; ++e) acc[e] = siluf(acc[e]) * sc;
                        u32x4 w; w.x = pk2(acc[0], acc[1]); w.y = pk2(acc[2], acc[3]); w.z = pk2(acc[4], acc[5]); w.w = pk2(acc[6], acc[7]);
                        __builtin_nontemporal_store(w, (u32x4*)SLA(QKC, r0 + t, col));
                        const float ks = __shfl(ksc, t);
                        if (which == 1) { u32x4 w2; w2.x = pk2(acc[0] * ks, acc[1] * ks); w2.y = pk2(acc[2] * ks, acc[3] * ks); w2.z = pk2(acc[4] * ks, acc[5] * ks); w2.w = pk2(acc[6] * ks, acc[7] * ks);
                            *(u32x4*)(KE + t * QS + c8) = w2; }
                    }
                }
            } else {
                const float mprev = rf2; const float inter = bc + mprev; const float bt = ig - bc; const float bm = wave_scan_max(bt);
                const float mrow = fmaxf(inter, bc + bm);
                if (wid == 0) { alpha[lane] = bc - mrow; beta[lane] = bt; wrow[lane] = expf(inter - mrow); emr[lane] = expf(-mrow); }
                if (tid < 128) nprl[tid] = rf3;
                { const int tt = tid >> 4, c8 = (tid & 15) * 8; *(u32x4*)(QE + tt * QS + c8) = ra0; *(u32x4*)(KE + tt * QS + c8) = ra2; }
                { const int tt = (tid + 512) >> 4, c8 = (tid & 15) * 8; *(u32x4*)(QE + tt * QS + c8) = ra1; *(u32x4*)(KE + tt * QS + c8) = ra3; }
            }
        }
#pragma unroll
        for (int j = 0; j < NVL; ++j) { const int idx = tid + j * 512, t = (idx >> 4) & 63, v8 = (idx >> 10) * 128 + (idx & 15) * 8;
            *(u32x4*)(VV + t * VS + v8) = VPRE ? vld[j] : *(const u32x4*)SLA(P16, r0 + t, vcol0 + h * DV + v8); }
        if (PASS3 && tid < 64) ssq[tid] = 0.f;
    };

    int it = blockIdx.x;
    if (it < 2048) { issue(it); if (PASS3) { issue_sb(it); issue_gt(it); } }
    for (; it < 2048; it += G) {
        tid = ltid(); lane = tid & 63; wid = tid >> 6; fr = lane & 15; fq = lane >> 4; v0 = wid * (DV / 8);
        const int c = it & 255, bh = it >> 8, b = bh >> 2, h = bh & 3;
        const int r0 = b * SEQ + c * 64;
        bf16_t* STi = ST + (size_t)it * EPC;
        transform(it);
        lds_barrier();
        if (it + G < 2048) issue(it + G);
        __builtin_amdgcn_sched_barrier(0);

        if (!PASS3) {
            constexpr int MT = DV / 128;
            f32x4 acc[MT][8];
#pragma unroll
            for (int m = 0; m < MT; ++m)
#pragma unroll
                for (int n = 0; n < 8; ++n) acc[m][n] = (f32x4){0.f, 0.f, 0.f, 0.f};
#pragma unroll
            for (int ks = 0; ks < 2; ++ks) {
                bf16x8 va[MT];
#pragma unroll
                for (int m = 0; m < MT; ++m) va[m] = trfrag(VV, VS, ks * 32, v0 + m * 16, lane);
#pragma unroll
                for (int n = 0; n < 8; ++n) { const bf16x8 kb = trfrag(KE, QS, ks * 32, n * 16, lane);
#pragma unroll
                    for (int m = 0; m < MT; ++m) acc[m][n] = MFMA16(kb, va[m], acc[m][n]); }
            }
#pragma unroll
            for (int m = 0; m < MT; ++m)
#pragma unroll
                for (int n = 0; n < 8; ++n) { u32x2 w; w.x = pk2(acc[m][n][0], acc[m][n][1]); w.y = pk2(acc[m][n][2], acc[m][n][3]);
                    *(u32x2*)(STi + ((((wid * NT + m) * 4 + (n >> 1)) * 64 + ((n & 1) * 2 + (fq >> 1)) * 16 + fr) << 3) + (fq & 1) * 4) = w; }
            if (MIX == 2 && tid < 128) { float s = 0.f;
#pragma unroll 8
                for (int t = 0; t < 64; ++t) s += bf2f(KE[t * QS + tid]);
                NLOC[(size_t)it * 128 + tid] = s; }
            lds_barrier();
        } else {
            {
                const int ti = wid >> 1;
#pragma unroll
                for (int sj = 0; sj < 2; ++sj) {
                    const int si = (wid & 1) * 2 + sj;
                    f32x4 acc = {0.f, 0.f, 0.f, 0.f};
                    if (si <= ti) {
#pragma unroll
                        for (int kk = 0; kk < 4; ++kk) { const bf16x8 a = *(const bf16x8*)(QE + (ti * 16 + fr) * QS + kk * 32 + fq * 8); const bf16x8 bb = *(const bf16x8*)(KE + (si * 16 + fr) * QS + kk * 32 + fq * 8);
                            acc = MFMA16(a, bb, acc); }
                    }
                    const int s = si * 16 + fr; const float be = (MIX == 0) ? 0.f : beta[s];
#pragma unroll
                    for (int j = 0; j < 4; ++j) { const int t = ti * 16 + fq * 4 + j; float v = 0.f;
                        if (si <= ti && s <= t) v = (MIX == 0) ? acc[j] : acc[j] * __expf(alpha[t] + be);
                        PP[t * PS + s] = f2bf(v); }
                }
            }
            lds_barrier();
            if (MIX == 2) {
                const int t = tid >> 3, part = tid & 7;
                const bf16x8 pv = *(const bf16x8*)(PP + t * PS + part * 8);
                float sp = 0.f, qn = 0.f;
#pragma unroll
                for (int e = 0; e < 8; ++e) sp += bf2f((bf16_t)pv[e]);
#pragma unroll
                for (int g2 = 0; g2 < 2; ++g2) { const bf16x8 qv = *(const bf16x8*)(QE + t * QS + part * 16 + g2 * 8);
#pragma unroll
                    for (int e = 0; e < 8; ++e) qn += bf2f((bf16_t)qv[e]) * nprl[part * 16 + g2 * 8 + e]; }
                sp += wrow[t] * qn;
                sp += DPPF(0.f, sp, 0xB1, 0xf); sp += DPPF(0.f, sp, 0x4E, 0xf); sp += DPPF(0.f, sp, 0x141, 0xf);
                if (part == 0) den[t] = sp;
            }
            __builtin_amdgcn_sched_barrier(0);
            f32x4 acc[4][NT];
#pragma unroll
            for (int ti = 0; ti < 4; ++ti)
#pragma unroll
                for (int n = 0; n < NT; ++n) acc[ti][n] = (f32x4){0.f, 0.f, 0.f, 0.f};
#pragma unroll
            for (int kk = 0; kk < 4; ++kk)
#pragma unroll
                for (int ti = 0; ti < 4; ++ti) { const bf16x8 a = *(const bf16x8*)(QE + (ti * 16 + fr) * QS + kk * 32 + fq * 8);
#pragma unroll
                    for (int n = 0; n < NT; ++n) acc[ti][n] = MFMA16(a, sbn[n][kk], acc[ti][n]); }
            __builtin_amdgcn_sched_barrier(0);
            if (it + G < 2048) issue_sb(it + G);
            __builtin_amdgcn_sched_barrier(0);
            if (MIX != 0) {
#pragma unroll
                for (int ti = 0; ti < 4; ++ti)
#pragma unroll
                    for (int j = 0; j < 4; ++j) { const float w = wrow[ti * 16 + fq * 4 + j];
#pragma unroll
                        for (int n = 0; n < NT; ++n) acc[ti][n][j] *= w; }
            }
#pragma unroll
            for (int ks = 0; ks < 2; ++ks) {
                bf16x8 vb[NT];
#pragma unroll
                for (int n = 0; n < NT; ++n) vb[n] = trfrag(VV, VS, ks * 32, v0 + n * 16, lane);
#pragma unroll
                for (int ti = 0; ti < 4; ++ti) { const bf16x8 a = *(const bf16x8*)(PP + (ti * 16 + fr) * PS + ks * 32 + fq * 8);
#pragma unroll
                    for (int n = 0; n < NT; ++n) acc[ti][n] = MFMA16(a, vb[n], acc[ti][n]); }
            }
            lds_barrier();
#pragma unroll
            for (int ti = 0; ti < 4; ++ti)
#pragma unroll
                for (int j = 0; j < 4; ++j) { const int t = ti * 16 + fq * 4 + j; float s = 0.f;
                    float inv = 1.f;
                    if (MIX == 2) inv = __builtin_amdgcn_rcpf(fmaxf(fabsf(den[t]), emr[t]));
#pragma unroll
                    for (int n = 0; n < NT; ++n) { const float o = acc[ti][n][j] * inv; OL[t * OS + v0 + n * 16 + fr] = o; s += o * o; }
                    s = row16_sum(s);
                    if (fr == 0) atomicAdd(&ssq[t], s); }
            lds_barrier();
            {
                constexpr int ycol0 = (MIX == 1) ? 512 : 0;
#pragma unroll
                for (int j = 0; j < NJ; ++j) {
                    const int idx = tid + j * 512, t = (idx >> 4) & 63, v8 = (idx >> 10) * 128 + (idx & 15) * 8;
                    const float rstd = rsqrtf(ssq[t] * (1.f / (float)DV) + 1e-6f);
                    const u32x4 gt = gtn[j];
                    const f32x4 o0 = *(const f32x4*)(OL + t * OS + v8), o1 = *(const f32x4*)(OL + t * OS + v8 + 4);
                    const f32x4 g0 = *(const f32x4*)(gnl + v8), g1 = *(const f32x4*)(gnl + v8 + 4);
                    float gv[8] = {lo16(gt[0]), hi16(gt[0]), lo16(gt[1]), hi16(gt[1]), lo16(gt[2]), hi16(gt[2]), lo16(gt[3]), hi16(gt[3])};
                    float y[8];
#pragma unroll
                    for (int e = 0; e < 8; ++e) { const float o = (e < 4) ? o0[e & 3] : o1[e & 3]; const float g = (e < 4) ? g0[e & 3] : g1[e & 3];
                        const float act = (MIX == 2) ? sigmf(gv[e]) : siluf(gv[e]);
                        y[e] = o * rstd * g * act; }
                    u32x4 w; w.x = pk2(y[0], y[1]); w.y = pk2(y[2], y[3]); w.z = pk2(y[4], y[5]); w.w = pk2(y[6], y[7]);
                    *(u32x4*)(Y16 + (size_t)(r0 + t) * LDY + ycol0 + h * DV + v8) = w;
                }
            }
            if (it + G < 2048) issue_gt(it + G);
            lds_barrier();
        }
    }
}

template <int MIX>
DI void scan_phase(const Params& p) {
    constexpr int DV = MixC<MIX>::DV, EPC = DV * 128, HPC = EPC / 2, SU = 16;
    unsigned char* ws = p.ws;
    bf16_t* ST = (bf16_t*)(ws + (MIX == 2 ? O_ST_L1 : O_ST_L0));
    const float* HGDEC = (const float*)(ws + O_HGDEC); const float* NLOC = (const float*)(ws + O_NLOC); float* NPREV = (float*)(ws + O_NPREV);
    const float* BLAST = (const float*)(ws + O_SCAL); const float* MLOC = BLAST + 2048; float* MPREV = (float*)(ws + O_SCAL) + 4096;
    for (int e = blockIdx.x * 512 + ltid(); e < 8 * HPC; e += gridDim.x * 512) {
        const int chain = e / HPC, off = (e % HPC) * 2, v = off >> 7;
        const int d = (MIX == 0) ? ((((off >> 9) & 3) << 5) + (((off >> 7) & 3) << 3) + (off & 7)) : (off & 127);
        bf16_t* base = ST + (size_t)chain * 256 * EPC + off;
        float s0 = 0.f, s1 = 0.f, m = 0.f, n0 = 0.f, n1 = 0.f;
        float cd = 1.f;
        if (MIX == 1) cd = __expf(64.f * log1pf(-exp2f(-5.f - (float)(chain & 3))));
        unsigned hv[SU], hn[SU]; float dx[SU], dy[SU], dxn[SU], dyn[SU];
#define SCAN_LOAD(H, DX, DY, C0) do { _Pragma("unroll") for (int u = 0; u < SU; ++u) { H[u] = __builtin_nontemporal_load((const unsigned*)(base + (size_t)((C0) + u) * EPC)); \
            if (MIX == 0) { const float2 dd = *(const float2*)(HGDEC + (size_t)(chain * 256 + (C0) + u) * 128 + d); DX[u] = dd.x; DY[u] = dd.y; } \
            if (MIX == 2) { DX[u] = BLAST[chain * 256 + (C0) + u]; DY[u] = MLOC[chain * 256 + (C0) + u]; } } } while (0)
        SCAN_LOAD(hv, dx, dy, 0);
        for (int c0 = 0; c0 < 256; c0 += SU) {
            if (c0 + SU < 256) SCAN_LOAD(hn, dxn, dyn, c0 + SU);
#pragma unroll
            for (int u = 0; u < SU; ++u) {
                const int ci = chain * 256 + c0 + u;
                *(unsigned*)(base + (size_t)(c0 + u) * EPC) = pk2(s0, s1);
                const float h0 = lo16(hv[u]), h1 = hi16(hv[u]);
                if (MIX == 0) { s0 = dx[u] * s0 + h0; s1 = dy[u] * s1 + h1; }
                else if (MIX == 1) { s0 = cd * s0 + h0; s1 = cd * s1 + h1; }
                else {
                    const float bl = dx[u], ml = dy[u]; const float mn = fmaxf(bl + m, ml); const float sp = __expf(bl + m - mn), sl = __expf(ml - mn);
                    if (v == 0) { *(float2*)(NPREV + (size_t)ci * 128 + d) = make_float2(n0, n1); const float2 nl = *(const float2*)(NLOC + (size_t)ci * 128 + d);
                        n0 = sp * n0 + sl * nl.x; n1 = sp * n1 + sl * nl.y; if (d == 0) MPREV[ci] = m; }
                    s0 = sp * s0 + sl * h0; s1 = sp * s1 + sl * h1; m = mn;
                }
            }
#pragma unroll
            for (int u = 0; u < SU; ++u) { hv[u] = hn[u]; dx[u] = dxn[u]; dy[u] = dyn[u]; }
        }
#undef SCAN_LOAD
    }
}

#ifndef PH_MASK
#define PH_MASK 0x3fffff
#endif
#define EN(n) if constexpr (((PH_MASK) >> (n)) & 1)
DI void run_phase(const Params& p, int ph) {
    unsigned char* ws = p.ws;
    switch (ph) {
        case 0: EN(0) prep_phase(p); break;
        case 1: case 8: case 10: case 11: case 13: case 17: case 19: case 20: EN(1) run_gemm(p, ph); break;
        case 2: EN(2) chunk_phase<0, false>(p); break;
        case 3: EN(3) scan_phase<0>(p); break;
        case 4: EN(4) chunk_phase<0, true>(p); break;
        case 5: EN(5) chunk_phase<1, false>(p); break;
        case 6: EN(6) scan_phase<1>(p); break;
        case 7: EN(7) chunk_phase<1, true>(p); break;
        case 9:  EN(9) row_phase<1, false>((const bf16_t*)(ws + O_Z32), p.x, p.out, p.norm_g + 1 * 1024, p.norm_g + 2 * 1024, (bf16_t*)(ws + O_H16B), nullptr, nullptr); break;
        case 12: EN(12) row_phase<1, true>((const bf16_t*)(ws + O_Z32), p.out, p.out, p.norm_g + 3 * 1024, p.norm_g + 4 * 1024, (bf16_t*)(ws + O_H16B), p.od_w_in, (float*)(ws + O_G32)); break;
        case 14: EN(14) chunk_phase<2, false>(p); break;
        case 15: EN(15) scan_phase<2>(p); break;
        case 16: EN(16) chunk_phase<2, true>(p); break;
        case 18: EN(18) row_phase<1, false>((const bf16_t*)(ws + O_Z32), p.out, p.out, p.norm_g + 5 * 1024, p.norm_g + 6 * 1024, (bf16_t*)(ws + O_H16B), nullptr, nullptr); break;
        case 21: EN(21) row_phase<2, false>((const bf16_t*)(ws + O_Z32), p.out, p.out, p.norm_g + 7 * 1024, nullptr, nullptr, nullptr, nullptr); break;
        default: break;
    }
}
constexpr int N_PHASES = 22;

__global__ void __launch_bounds__(512, 2) mega(Params p) {
    cg::grid_group grid = cg::this_grid();
    volatile LAS unsigned* st = (volatile LAS unsigned*)(smem + 131072);
    unsigned* bar = (unsigned*)(p.ws + O_BAR);
    if (threadIdx.x < 4) st[threadIdx.x] = 0u;
    if (blockIdx.x == 0) for (int i = threadIdx.x; i < XCD_BAR_WORDS; i += 512) bar[i] = 0u;
    __syncthreads();
    XcdBarrier xb; xb.bar = bar; xb.x = 0u; xb.st = st;
    for (int ph = p.phase_lo; ph < p.phase_hi; ++ph) {
        size_t zo = 0; asm volatile("s_mov_b64 %0, 0" : "=s"(zo));
        Params q = p;
        q.x = p.x + zo; q.norm_g = p.norm_g + zo; q.hg_lb = p.hg_lb + zo; q.ev_w_in = p.ev_w_in + zo; q.ev_hg_g = p.ev_hg_g + zo; q.ev_ret_g = p.ev_ret_g + zo; q.ev_w_out = p.ev_w_out + zo;
        q.od_w_in = p.od_w_in + zo; q.od_conv_w = p.od_conv_w + zo; q.od_conv_b = p.od_conv_b + zo; q.od_gate_b = p.od_gate_b + zo; q.od_ml_g = p.od_ml_g + zo; q.od_w_out = p.od_w_out + zo;
        q.mlp_w1 = p.mlp_w1 + zo; q.mlp_w2 = p.mlp_w2 + zo; q.out = p.out + zo; q.ws = p.ws + zo;
#ifdef REP_MASK
        for (int rep = 0; rep < 1 + (int)(((REP_MASK) >> ph) & 1); ++rep) { if (rep) __syncthreads(); run_phase(q, ph); }
#else
        run_phase(q, ph);
#endif
        if (ph + 1 < p.phase_hi) {
            if (ph == p.phase_lo) { grid.sync(); xb = xcd_barrier_post(bar, st); }
            else xcd_barrier(xb);
        }
#ifdef EXTRA_SYNC
        for (int k = 0; k < EXTRA_SYNC; ++k) xcd_barrier(xb);
#endif
    }
}

extern "C" void kernel_launch(void* const* d_in, const int* in_sizes, int n_in, void* d_out, int out_size, void* d_ws, size_t ws_size, hipStream_t stream) {
    static int grid_blocks = 0;
    if (!grid_blocks) {
        int dev = 0, cus = 0, per_cu = 0;
        hipGetDevice(&dev);
        hipDeviceGetAttribute(&cus, hipDeviceAttributeMultiprocessorCount, dev);
        hipFuncSetAttribute((const void*)mega, hipFuncAttributeMaxDynamicSharedMemorySize, LDS_BYTES);
        hipOccupancyMaxActiveBlocksPerMultiprocessor(&per_cu, mega, 512, LDS_BYTES);
        if (per_cu > 1) per_cu = 1;
        grid_blocks = cus * per_cu;
        if (grid_blocks <= 0) { fprintf(stderr, "occupancy query failed (cus %d per_cu %d)\n", cus, per_cu); grid_blocks = 0; return; }
    }
    if (ws_size < WS_NEED) { fprintf(stderr, "workspace too small: %zu < %zu\n", ws_size, (size_t)WS_NEED); return; }
    Params p{};
    p.x = (const float*)d_in[0]; p.norm_g = (const float*)d_in[1]; p.hg_lb = (const float*)d_in[2]; p.ev_w_in = (const float*)d_in[3]; p.ev_hg_g = (const float*)d_in[4];
    p.ev_ret_g = (const float*)d_in[5]; p.ev_w_out = (const float*)d_in[6]; p.od_w_in = (const float*)d_in[7]; p.od_conv_w = (const float*)d_in[8]; p.od_conv_b = (const float*)d_in[9];
    p.od_gate_b = (const float*)d_in[10]; p.od_ml_g = (const float*)d_in[11]; p.od_w_out = (const float*)d_in[12]; p.mlp_w1 = (const float*)d_in[13]; p.mlp_w2 = (const float*)d_in[14];
    p.out = (float*)d_out; p.ws = (unsigned char*)d_ws; p.phase_lo = 0; p.phase_hi = N_PHASES;
    void* args[] = {&p};
    hipError_t e = hipLaunchCooperativeKernel((const void*)mega, dim3(grid_blocks), dim3(512), args, LDS_BYTES, stream);
    if (e != hipSuccess) fprintf(stderr, "cooperative launch failed: %s (grid %d)\n", hipGetErrorString(e), grid_blocks);
}
```

```cpp
#include <hip/hip_runtime.h>
#include <hip/hip_cooperative_groups.h>
#include <cstdio>
namespace cg = cooperative_groups;
#define LAS __attribute__((address_space(3)))

#define XB_TMO      128
#define XB_XCNT(j)  (256  + 64 * (j))
#define XB_XSUB(j)  (1280 + 64 * (j))
#define XB_XGEN(j)  (2304 + 64 * (j))
#define XB_TOP      3328
#define XB_TOPGEN   3392
#define XCD_BAR_WORDS 3456
#define XB_SPIN_CAP (1u << 18)

__device__ __forceinline__ unsigned xb_ld(unsigned* p)              { return __hip_atomic_load(p, __ATOMIC_RELAXED, __HIP_MEMORY_SCOPE_AGENT); }
__device__ __forceinline__ unsigned xb_add(unsigned* p, unsigned v) { return __hip_atomic_fetch_add(p, v, __ATOMIC_RELAXED, __HIP_MEMORY_SCOPE_AGENT); }
__device__ __forceinline__ unsigned xb_xcc_id() { return (unsigned)__builtin_amdgcn_s_getreg((3 << 11) | 20) & 0xFu; }
#define XB_SPIN(cond, bar) do { unsigned _sp = 0; while (cond) { __builtin_amdgcn_s_sleep(1); \
    if ((++_sp & 255u) == 0u) { if (xb_ld(&(bar)[XB_TMO])) break; if (_sp > XB_SPIN_CAP) { atomicAdd(&(bar)[XB_TMO], 1u); break; } } } } while (0)

struct XcdBarrier {
    unsigned* bar; unsigned x;
    volatile LAS unsigned* st;
};

__device__ __forceinline__ XcdBarrier xcd_barrier_post(unsigned* bar, volatile LAS unsigned* st) {
    XcdBarrier b; b.bar = bar; b.x = xb_xcc_id(); b.st = st;
    if (threadIdx.x == 0) (void)xb_add(&bar[XB_XCNT(b.x)], 1u);
    return b;
}
__device__ __forceinline__ void xcd_barrier_complete(unsigned* bar, unsigned x, unsigned& nloc, unsigned& nx) {
    const unsigned G = gridDim.x * gridDim.y * gridDim.z;
    unsigned sum, cnt, mine, sp = 0u;
    for (;;) {
        sum = 0u; cnt = 0u; mine = 0u;
#pragma unroll
        for (unsigned j = 0; j < 16; ++j) { const unsigned c = xb_ld(&bar[XB_XCNT(j)]); sum += c; cnt += (c > 0u) ? 1u : 0u; mine = (j == x) ? c : mine; }
        if (sum == G) break;
        __builtin_amdgcn_s_sleep(1);
        if ((++sp & 255u) == 0u) { if (xb_ld(&bar[XB_TMO])) break; if (sp > XB_SPIN_CAP) { atomicAdd(&bar[XB_TMO], 1u); break; } }
    }
    nloc = mine > 0u ? mine : 1u; nx = cnt > 0u ? cnt : 1u;
}

__device__ __forceinline__ void xcd_barrier(const XcdBarrier& b) {
    asm volatile("s_waitcnt vmcnt(0)" ::: "memory");
    __syncthreads();
    if (threadIdx.x == 0) {
        unsigned* bar = b.bar;
        __builtin_amdgcn_s_waitcnt(0);
        unsigned nloc = b.st[0], nx = b.st[1];
        if (nloc == 0u) { xcd_barrier_complete(bar, b.x, nloc, nx); b.st[0] = nloc; b.st[1] = nx; }
        const unsigned old = xb_add(&bar[XB_XSUB(b.x)], 1u);
        const unsigned gen = old / nloc;
        if (old + 1u == (gen + 1u) * nloc) {
            __builtin_amdgcn_fence(__ATOMIC_RELEASE, "agent");
            asm volatile("s_waitcnt vmcnt(0)" ::: "memory");
            const unsigned og = xb_add(&bar[XB_TOP], 1u);
            const unsigned tg = og / nx;
            if (og + 1u == (tg + 1u) * nx) xb_add(&bar[XB_TOPGEN], 1u);
            else XB_SPIN(xb_ld(&bar[XB_TOPGEN]) == tg, bar);
            __builtin_amdgcn_fence(__ATOMIC_ACQUIRE, "agent");
            xb_add(&bar[XB_XGEN(b.x)], 1u);
            asm volatile("s_waitcnt vmcnt(0)" ::: "memory");
        } else {
            XB_SPIN(xb_ld(&bar[XB_XGEN(b.x)]) == gen, bar);
            __builtin_amdgcn_fence(__ATOMIC_ACQUIRE, "agent");
            asm volatile("s_waitcnt vmcnt(0)" ::: "memory");
        }
    }
    __syncthreads();
}
__device__ __forceinline__ int ltid() { int t = threadIdx.x; asm volatile("" : "+v"(t)); return t; }
namespace pg8 {
#define PG8_LAS __attribute__((address_space(3)))
typedef unsigned short bf16_t;
typedef short bf16x8 __attribute__((ext_vector_type(8)));
typedef float f32x4 __attribute__((ext_vector_type(4)));
typedef unsigned u32x4 __attribute__((ext_vector_type(4)));
constexpr int BM = 256, BK = 64, HALF = 128, HTB = HALF * BK * 2  , STAGE_BYTES = 8 * HTB, NXCD = 8, WGM = 8;

__host__ __device__ __forceinline__ int lds_byte(int r, int c) { const int st = (r >> 4) * 2 + (c >> 5), rr = r & 15, cc = c & 31, ob = rr * 64 + cc * 2; return st * 1024 + (ob ^ (((ob >> 9) & 1) << 5)); }
__host__ __device__ __forceinline__ void stage_rc(int b, int& R, int& C) { const int st = b / 1024, sb = b % 1024, swz = sb ^ (((sb >> 9) & 1) << 5); R = (st >> 1) * 16 + swz / 64; C = (st & 1) * 32 + (swz % 64) / 2; }
__host__ __device__ __forceinline__ int perm32(int rho) { const int n = rho >> 4, i = rho & 15; return 8 * (i >> 2) + 4 * n + (i & 3); }

struct Unit { int pm, pn; };
struct Gemm { const bf16_t* A; const bf16_t* Bt; int M, N, K; };

struct StaticOrder {
    int nM, nN, nwg, G, c;
    __host__ __device__ void init(int M, int N, int G_, int c_) { nM = M / BM; nN = N / BM; nwg = nM * nN; G = G_; c = c_; }
    __host__ __device__ bool next(int i, Unit& u) const {
        const long L = (long)i * G + c; if (L >= nwg) return false;
        int wgid = (int)L; { const int q = nwg / NXCD, r = nwg % NXCD, xcd = wgid % NXCD, off = wgid / NXCD; wgid = (xcd < r ? xcd * (q + 1) : r * (q + 1) + (xcd - r) * q) + off; }
        const int nig = WGM * nN, gid = wgid / nig, fm = gid * WGM, gsz = (nM - fm) < WGM ? (nM - fm) : WGM;
        u.pm = fm + ((wgid % nig) % gsz); u.pn = (wgid % nig) / gsz; return true;
    }
    __device__ __forceinline__ void a_ready(const Unit&) const {}
    __device__ __forceinline__ void done(const Unit&) const {}
};
__device__ __forceinline__ unsigned cvt_pk_bf16(float lo, float hi) { unsigned r; asm volatile("v_cvt_pk_bf16_f32 %0, %1, %2" : "=v"(r) : "v"(lo), "v"(hi)); return r; }
struct EpiF32 {
    static constexpr bool PERM = false, AFTER_DRAIN = false;
    float* C; int ldc; const float* bias;
    __device__ __forceinline__ void operator()(const f32x4 (&acc)[2][2][4][2], const Unit& u, int wr, int wc, int fr, int fq) const {
        const int row0 = u.pm * BM + wr * 64 + fr, col0 = u.pn * BM + wc * 32 + 4 * fq;
        f32x4 bv[2][2];
#pragma unroll
        for (int bj = 0; bj < 2; ++bj)
#pragma unroll
            for (int n = 0; n < 2; ++n) bv[bj][n] = bias ? *(const f32x4*)(bias + col0 + bj * HALF + n * 16) : (f32x4){0.f, 0.f, 0.f, 0.f};
#pragma unroll
        for (int ai = 0; ai < 2; ++ai)
#pragma unroll
            for (int m = 0; m < 4; ++m) { float* rowp = C + (size_t)(row0 + ai * HALF + m * 16) * ldc + col0;
#pragma unroll
                for (int bj = 0; bj < 2; ++bj)
#pragma unroll
                    for (int n = 0; n < 2; ++n) *(f32x4*)(rowp + bj * HALF + n * 16) = acc[ai][bj][m][n] + bv[bj][n]; }
    }
};
template <class Epi, class Sched, bool STAMP = false>
__device__ __forceinline__ void gemm_phase(PG8_LAS unsigned char* lds, const Gemm g, const Sched& S, const Epi& E, unsigned long long* stamps) {
    const int tid = ltid(), wid = __builtin_amdgcn_readfirstlane(tid >> 6), lane = tid & 63, wr = wid >> 2, wc = wid & 3, fr = lane & 15, fq = lane >> 4;
    const int K = g.K, nt = K / BK;
    int ts_lo = 0, ts_hi = 0, nts = 0; const unsigned long long rt_entry = STAMP ? (unsigned long long)wall_clock64() : 0ull;
#define PG8_STAMP() do { if (STAMP && wid == 0 && nts < 64) { const unsigned long long _c = (unsigned long long)clock64(); \
        ts_lo = (lane == nts) ? (int)(unsigned)_c : ts_lo; ts_hi = (lane == nts) ? (int)(unsigned)(_c >> 32) : ts_hi; ++nts; } } while (0)
    PG8_STAMP();
    unsigned voffA[2], voffB[2];
#pragma unroll
    for (int i = 0; i < 2; ++i) { int R, C; stage_rc(tid * 16 + i * 8192, R, C); const int Rb = Epi::PERM ? ((R & ~31) + perm32(R & 31)) : R;
        voffA[i] = (unsigned)(R * K + C) * 2u; voffB[i] = (unsigned)(Rb * K + C) * 2u; }
    const size_t kstep = (size_t)(BK * 2);
    const size_t hstep = (size_t)HALF * K * 2;
    const size_t tstep = 2 * hstep;
    const unsigned ldsw = (unsigned)wid * 1024u;
    const int aoff = lds_byte(wr * 64 + fr, fq * 8), boff = lds_byte(wc * 32 + fr, fq * 8);
#define PG8_SA(b, h) (((b) * 2 + (h)) * HTB)
#define PG8_SB(b, h) ((4 + (b) * 2 + (h)) * HTB)
#define PG8_STAGE(bufoff, gbase, voff) do { _Pragma("unroll") for (int _i = 0; _i < 2; ++_i) \
        __builtin_amdgcn_global_load_lds((const unsigned*)((const char*)(gbase) + (voff)[_i]), (PG8_LAS unsigned*)(lds + (bufoff) + ldsw + _i * 8192), 16, 0, 0); } while (0)
#define PG8_LDA(dst, b, h) do { _Pragma("unroll") for (int m = 0; m < 4; ++m) _Pragma("unroll") for (int k = 0; k < 2; ++k) dst[m][k] = *(const PG8_LAS bf16x8*)(lds + PG8_SA(b, h) + aoff + m * 2048 + k * 1024); } while (0)
#define PG8_LDB(dst, b, h) do { _Pragma("unroll") for (int n = 0; n < 2; ++n) _Pragma("unroll") for (int k = 0; k < 2; ++k) dst[n][k] = *(const PG8_LAS bf16x8*)(lds + PG8_SB(b, h) + boff + n * 2048 + k * 1024); } while (0)
#define PG8_MMA(ai, bj, At, Bt) do { __builtin_amdgcn_s_setprio(1); _Pragma("unroll") for (int m = 0; m < 4; ++m) _Pragma("unroll") for (int n = 0; n < 2; ++n) _Pragma("unroll") for (int k = 0; k < 2; ++k) \
        acc[ai][bj][m][n] = __builtin_amdgcn_mfma_f32_16x16x32_bf16(Bt[n][k], At[m][k], acc[ai][bj][m][n], 0, 0, 0); __builtin_amdgcn_s_setprio(0); } while (0)
#define PG8_WAIT_V(n) asm volatile("s_waitcnt vmcnt(" #n ")" ::: "memory")
#define PG8_WAIT_L(n) asm volatile("s_waitcnt lgkmcnt(" #n ")" ::: "memory")
#define PG8_BAR __builtin_amdgcn_s_barrier()
#define PG8_SCHED __builtin_amdgcn_sched_barrier(0)
    Unit cur, nxt; int ui = 0;
    if (!S.next(0, cur)) return;
    f32x4 acc[2][2][4][2];
#pragma unroll
    for (int a = 0; a < 2; ++a)
#pragma unroll
        for (int b = 0; b < 2; ++b)
#pragma unroll
            for (int m = 0; m < 4; ++m)
#pragma unroll
                for (int n = 0; n < 2; ++n) acc[a][b][m][n] = (f32x4){0.f, 0.f, 0.f, 0.f};
    bf16x8 At[4][2], B0[2][2], B1[2][2];
    const char* cA = (const char*)g.A + (size_t)cur.pm * tstep; const char* cB = (const char*)g.Bt + (size_t)cur.pn * tstep;
    S.a_ready(cur);
    PG8_STAGE(PG8_SB(0, 0), cB, voffB); PG8_STAGE(PG8_SA(0, 0), cA, voffA); PG8_STAGE(PG8_SB(0, 1), cB + hstep, voffB); PG8_STAGE(PG8_SA(0, 1), cA + hstep, voffA);
    if (wr == 1) PG8_BAR;
    PG8_WAIT_V(4); PG8_BAR;
    PG8_STAGE(PG8_SB(1, 0), cB + kstep, voffB); PG8_STAGE(PG8_SA(1, 0), cA + kstep, voffA); PG8_STAGE(PG8_SB(1, 1), cB + hstep + kstep, voffB);
    PG8_WAIT_V(6); PG8_BAR;
    PG8_STAMP();
    for (;;) {
        const bool has_next = S.next(ui + 1, nxt);
        const char* nA = has_next ? (const char*)g.A + (size_t)nxt.pm * tstep : cA; const char* nB = has_next ? (const char*)g.Bt + (size_t)nxt.pn * tstep : cB;
        for (int t = 0; t < nt; t += 2) {
            const bool last = (t == nt - 2);
            const char* a1 = cA + (size_t)(t + 1) * kstep;
            const char* a2 = last ? nA : cA + (size_t)(t + 2) * kstep; const char* b2 = last ? nB : cB + (size_t)(t + 2) * kstep;
            const char* a3 = a2 + kstep; const char* b3 = b2 + kstep;
            if (last && has_next) S.a_ready(nxt);
            PG8_LDB(B0, 0, 0); PG8_SCHED; PG8_LDA(At, 0, 0); PG8_STAGE(PG8_SA(1, 1), a1 + hstep, voffA);
            PG8_WAIT_L(8); PG8_BAR; PG8_WAIT_L(0); PG8_MMA(0, 0, At, B0); PG8_BAR; PG8_SCHED;
            PG8_LDB(B1, 0, 1); PG8_STAGE(PG8_SB(0, 0), b2, voffB);
            PG8_BAR; PG8_WAIT_L(0); PG8_MMA(0, 1, At, B1); PG8_BAR;
            PG8_LDA(At, 0, 1); PG8_STAGE(PG8_SA(0, 0), a2, voffA);
            PG8_BAR; PG8_WAIT_L(0); PG8_MMA(1, 0, At, B0); PG8_BAR; PG8_SCHED;
            PG8_STAGE(PG8_SB(0, 1), b2 + hstep, voffB);
            PG8_WAIT_V(6); PG8_BAR; PG8_MMA(1, 1, At, B1); PG8_BAR;
            PG8_LDB(B0, 1, 0); PG8_SCHED; PG8_LDA(At, 1, 0); PG8_STAGE(PG8_SA(0, 1), a2 + hstep, voffA);
            PG8_WAIT_L(8); PG8_BAR; PG8_WAIT_L(0); PG8_MMA(0, 0, At, B0); PG8_BAR; PG8_SCHED;
            PG8_LDB(B1, 1, 1); PG8_STAGE(PG8_SB(1, 0), b3, voffB);
            PG8_BAR; PG8_WAIT_L(0); PG8_MMA(0, 1, At, B1); PG8_BAR;
            PG8_LDA(At, 1, 1); PG8_STAGE(PG8_SA(1, 0), a3, voffA);
            PG8_BAR; PG8_WAIT_L(0); PG8_MMA(1, 0, At, B0); PG8_BAR; PG8_SCHED;
            PG8_STAGE(PG8_SB(1, 1), b3 + hstep, voffB);
            PG8_WAIT_V(6); PG8_BAR; PG8_MMA(1, 1, At, B1); PG8_BAR;
        }
        PG8_STAMP();
        if constexpr (!Epi::AFTER_DRAIN) { E(acc, cur, wr, wc, fr, fq); S.done(cur); }
        PG8_STAMP();
        if (!has_next) break;
#pragma unroll
        for (int a = 0; a < 2; ++a)
#pragma unroll
            for (int b = 0; b < 2; ++b)
#pragma unroll
                for (int m = 0; m < 4; ++m)
#pragma unroll
                    for (int n = 0; n < 2; ++n) acc[a][b][m][n] = (f32x4){0.f, 0.f, 0.f, 0.f};
        cur = nxt; cA = nA; cB = nB; ++ui;
    }
    PG8_WAIT_V(0);
    if (wr == 0) PG8_BAR;
    PG8_BAR;
    if constexpr (Epi::AFTER_DRAIN) { E.fused(acc, cur, wr, wc, fr, fq, lds, wid, lane); S.done(cur); }
    PG8_STAMP();
    if (STAMP && wid == 0) { stamps[lane] = lane < nts ? (((unsigned long long)(unsigned)ts_hi << 32) | (unsigned)ts_lo) : 0ull;
        if (lane == 62) stamps[62] = rt_entry; if (lane == 63) stamps[63] = (unsigned long long)wall_clock64(); }
#undef PG8_STAMP
#undef PG8_SA
#undef PG8_SB
#undef PG8_STAGE
#undef PG8_LDA
#undef PG8_LDB
#undef PG8_MMA
#undef PG8_WAIT_V
#undef PG8_WAIT_L
#undef PG8_BAR
#undef PG8_SCHED
}
}

using pg8::bf16_t; using pg8::bf16x8; using pg8::f32x4; using pg8::u32x4;
typedef short s16x4 __attribute__((ext_vector_type(4)));
typedef unsigned u32x2 __attribute__((ext_vector_type(2)));
#define DI __device__ __forceinline__
#define LAUNDER(ptr) asm volatile("" : "+s"(ptr))

constexpr int T_TOK = 32768, SEQ = 16384, DM = 1024;
constexpr int LDS_BYTES = 131072 + 256;
constexpr size_t MiB = 1ull << 20;
constexpr size_t W_IN0 = 0, W_OUT0 = 10 * MiB, W_UP0 = 13 * MiB, W_DN0 = 21 * MiB, W_IN1 = 29 * MiB, W_OUT1 = 35 * MiB, W_UP1 = 37 * MiB, W_DN1 = 45 * MiB;
constexpr size_t O_G32 = 53 * MiB, O_HGDEC = 54 * MiB, O_NLOC = 55 * MiB, O_NPREV = 56 * MiB, O_SCAL = 57 * MiB;
constexpr size_t O_P16_L0 = 58 * MiB, O_ST_L0 = 378 * MiB, O_H16A = 378 * MiB;
constexpr size_t O_Z32 = 58 * MiB, O_H16B = 186 * MiB, O_U16 = 250 * MiB;
constexpr size_t O_P16_L1 = 250 * MiB, O_ST_L1 = 58 * MiB, O_Y16_L1 = 442 * MiB;
constexpr size_t O_BAR = 57 * MiB + 65536;
constexpr size_t WS_NEED = 506 * MiB;

constexpr size_t SLS = (size_t)T_TOK * 128;
struct Params {
    const float *x, *norm_g, *hg_lb, *ev_w_in, *ev_hg_g, *ev_ret_g, *ev_w_out, *od_w_in, *od_conv_w, *od_conv_b, *od_gate_b, *od_ml_g, *od_w_out, *mlp_w1, *mlp_w2;
    float* out; unsigned char* ws; int phase_lo, phase_hi;
};

extern __shared__ __attribute__((aligned(16))) unsigned char smem[];

DI float bf2f(bf16_t b) { return __uint_as_float(((unsigned)b) << 16); }
typedef float f32x2_t __attribute__((ext_vector_type(2)));
typedef __bf16 bf16x2_t __attribute__((ext_vector_type(2)));
DI unsigned pk2(float lo, float hi) { const f32x2_t v = {lo, hi}; return __builtin_bit_cast(unsigned, __builtin_convertvector(v, bf16x2_t)); }
DI bf16_t f2bf(float f) { return (bf16_t)(pk2(f, f) & 0xffffu); }
DI float lo16(unsigned u) { return __uint_as_float(u << 16); }
DI float hi16(unsigned u) { return __uint_as_float(u & 0xffff0000u); }
DI float rdlane_(float v, int l) { return __builtin_bit_cast(float, __builtin_amdgcn_readlane(__builtin_bit_cast(int, v), l)); }
DI float row16_sum(float v);
DI float wave_sum(float v) { v = row16_sum(v); return (rdlane_(v, 0) + rdlane_(v, 16)) + (rdlane_(v, 32) + rdlane_(v, 48)); }
DI void lds_barrier() { __builtin_amdgcn_sched_barrier(0); asm volatile("s_waitcnt lgkmcnt(0)\n\ts_barrier" ::: "memory"); __builtin_amdgcn_sched_barrier(0); }
DI float tanh_fast(float x) { const float e = __expf(2.f * x); return (e - 1.f) * __builtin_amdgcn_rcpf(e + 1.f); }
DI float log1p_fast(float u) { const float ser = u * (1.f + u * (-0.5f + u * (0.33333333f + u * (-0.25f + u * (0.2f + u * (-0.16666667f + u * 0.14285714f)))))); return (u < 0.06f) ? ser : __logf(1.f + u); }
#define DPPF(OLD, V, CTRL, RMASK) __builtin_bit_cast(float, __builtin_amdgcn_update_dpp(__builtin_bit_cast(int, (float)(OLD)), __builtin_bit_cast(int, (float)(V)), (CTRL), (RMASK), 0xf, false))
DI float rdlane(float v, int l) { return __builtin_bit_cast(float, __builtin_amdgcn_readlane(__builtin_bit_cast(int, v), l)); }
DI float wave_scan_sum(float v) {
    v += DPPF(0.f, v, 0x111, 0xf); v += DPPF(0.f, v, 0x112, 0xf); v += DPPF(0.f, v, 0x114, 0xf); v += DPPF(0.f, v, 0x118, 0xf);
    v += DPPF(0.f, v, 0x142, 0xa); v += DPPF(0.f, v, 0x143, 0xc);
    return v;
}
DI float wave_scan_max(float v) {
    const float ninf = -__builtin_inff();
    v = fmaxf(v, DPPF(ninf, v, 0x111, 0xf)); v = fmaxf(v, DPPF(ninf, v, 0x112, 0xf)); v = fmaxf(v, DPPF(ninf, v, 0x114, 0xf)); v = fmaxf(v, DPPF(ninf, v, 0x118, 0xf));
    v = fmaxf(v, DPPF(ninf, v, 0x142, 0xa)); v = fmaxf(v, DPPF(ninf, v, 0x143, 0xc));
    return v;
}
DI float row16_sum(float v) {
    v += __builtin_bit_cast(float, __builtin_amdgcn_update_dpp(0, __builtin_bit_cast(int, v), 0x121, 0xf, 0xf, false));
    v += __builtin_bit_cast(float, __builtin_amdgcn_update_dpp(0, __builtin_bit_cast(int, v), 0x122, 0xf, 0xf, false));
    v += __builtin_bit_cast(float, __builtin_amdgcn_update_dpp(0, __builtin_bit_cast(int, v), 0x124, 0xf, 0xf, false));
    v += __builtin_bit_cast(float, __builtin_amdgcn_update_dpp(0, __builtin_bit_cast(int, v), 0x128, 0xf, 0xf, false));
    return v;
}
DI float siluf(float x) { return x * __builtin_amdgcn_rcpf(1.f + __expf(-x)); }
DI float sigmf(float x) { return __builtin_amdgcn_rcpf(1.f + __expf(-x)); }

struct EpiBf {
    static constexpr bool PERM = true, AFTER_DRAIN = false;
    bf16_t* O; int ldc; int relu2; int sl;
    __device__ __forceinline__ void operator()(const f32x4 (&acc)[2][2][4][2], const pg8::Unit& u, int wr, int wc, int fr, int fq) const {
        const int row0 = u.pm * 256 + wr * 64 + fr, col0 = u.pn * 256 + wc * 32 + 8 * fq;
#pragma unroll
        for (int ai = 0; ai < 2; ++ai)
#pragma unroll
            for (int m = 0; m < 4; ++m) { const int row = row0 + ai * 128 + m * 16;
                bf16_t* rowp = sl ? (O + (size_t)(col0 >> 7) * SLS + (size_t)row * 128 + (col0 & 127)) : (O + (size_t)row * ldc + col0);
                const size_t bjstep = sl ? SLS : (size_t)128;
#pragma unroll
                for (int bj = 0; bj < 2; ++bj) { f32x4 v0 = acc[ai][bj][m][0], v1 = acc[ai][bj][m][1];
                    if (relu2) {
#pragma unroll
                        for (int j = 0; j < 4; ++j) { float a = fmaxf(v0[j], 0.f), b = fmaxf(v1[j], 0.f); v0[j] = a * a; v1[j] = b * b; } }
                    u32x4 w; w.x = pk2(v0[0], v0[1]); w.y = pk2(v0[2], v0[3]); w.z = pk2(v1[0], v1[1]); w.w = pk2(v1[2], v1[3]);
                    if (relu2) __builtin_nontemporal_store(w, (u32x4*)(rowp + bj * bjstep)); else *(u32x4*)(rowp + bj * bjstep) = w; } }
    }
};

DI void run_gemm(const Params& p, int ph) {
    const bf16_t* A; const bf16_t* Bt; int N, K, kind; void* out;
    unsigned char* ws = p.ws;
    switch (ph) {
        case 1:  A = (const bf16_t*)(ws + O_H16A); Bt = (const bf16_t*)(ws + W_IN0); N = 5120; K = 1024; kind = 0; out = ws + O_P16_L0; break;
        case 8:  A = (const bf16_t*)p.out;          Bt = (const bf16_t*)(ws + W_OUT0); N = 1024; K = 1536; kind = 0; out = ws + O_Z32; break;
        case 10: A = (const bf16_t*)(ws + O_H16B); Bt = (const bf16_t*)(ws + W_UP0); N = 4096; K = 1024; kind = 1; out = ws + O_U16; break;
        case 11: A = (const bf16_t*)(ws + O_U16);  Bt = (const bf16_t*)(ws + W_DN0); N = 1024; K = 4096; kind = 0; out = ws + O_Z32; break;
        case 13: A = (const bf16_t*)(ws + O_H16B); Bt = (const bf16_t*)(ws + W_IN1); N = 3072; K = 1024; kind = 0; out = ws + O_P16_L1; break;
        case 17: A = (const bf16_t*)(ws + O_Y16_L1); Bt = (const bf16_t*)(ws + W_OUT1); N = 1024; K = 1024; kind = 0; out = ws + O_Z32; break;
        case 19: A = (const bf16_t*)(ws + O_H16B); Bt = (const bf16_t*)(ws + W_UP1); N = 4096; K = 1024; kind = 1; out = ws + O_U16; break;
        default: A = (const bf16_t*)(ws + O_U16);  Bt = (const bf16_t*)(ws + W_DN1); N = 1024; K = 4096; kind = 0; out = ws + O_Z32; break;
    }
    pg8::Gemm g; g.A = A; g.Bt = Bt; g.M = T_TOK; g.N = N; g.K = K;
    pg8::StaticOrder S; S.init(T_TOK, N, (int)gridDim.x, (int)blockIdx.x);
    if (kind == 2) { pg8::EpiF32 e; e.C = (float*)out; e.ldc = N; e.bias = nullptr; pg8::gemm_phase<pg8::EpiF32, pg8::StaticOrder, false>((PG8_LAS unsigned char*)smem, g, S, e, nullptr); }
    else { EpiBf e; e.O = (bf16_t*)out; e.ldc = N; e.relu2 = kind; e.sl = (ph == 1 || ph == 13) ? 1 : 0; pg8::gemm_phase<EpiBf, pg8::StaticOrder, false>((PG8_LAS unsigned char*)smem, g, S, e, nullptr); }
}

struct TileDesc { const float* W; bf16_t* Wt; int ldw, K, k0, n0; };
DI void load_row(const float* src, int lane, f32x4 (&v)[4]) {
#pragma unroll
    for (int i = 0; i < 4; ++i) v[i] = *(const f32x4*)(src + lane * 4 + i * 256);
}
DI void load_row_nt(const float* src, int lane, f32x4 (&v)[4]) {
#pragma unroll
    for (int i = 0; i < 4; ++i) v[i] = __builtin_nontemporal_load((const f32x4*)(src + lane * 4 + i * 256));
}
DI float row_ss(const f32x4 (&v)[4]) {
    float s = 0.f;
#pragma unroll
    for (int i = 0; i < 4; ++i) s += v[i][0] * v[i][0] + v[i][1] * v[i][1] + v[i][2] * v[i][2] + v[i][3] * v[i][3];
    return wave_sum(s);
}

template <int MODE, bool GATES>
DI void row_phase(const bf16_t* z, const float* xin, float* xo, const float* ga, const float* gb, bf16_t* hdst, const float* wg_src, float* g32) {
    const int tid = ltid(), lane = tid & 63, wid = tid >> 6;
    float* wgl = (float*)smem;
    if (GATES) {
        for (int idx = tid; idx < 1024 * 8; idx += 512) { const int k = idx >> 3, j = idx & 7; wgl[idx] = wg_src[(size_t)k * 3080 + 3072 + j]; }
        __syncthreads();
    }
    f32x4 gav[4], gbv[4];
    load_row(ga, lane, gav);
    if (MODE == 1) load_row(gb, lane, gbv);
    f32x4 xn[4]; u32x2 zn[4];
    const int rstride = gridDim.x * 8;
    int row = blockIdx.x * 8 + wid;
    if (row < T_TOK) { load_row_nt(xin + (size_t)row * DM, lane, xn);
        if (MODE != 0) {
#pragma unroll
            for (int i = 0; i < 4; ++i) zn[i] = __builtin_nontemporal_load((const u32x2*)(z + (size_t)row * DM + lane * 4 + i * 256)); } }
    for (; row < T_TOK; row += rstride) {
        f32x4 xv[4], hv[4]; u32x2 zr[4];
#pragma unroll
        for (int i = 0; i < 4; ++i) { xv[i] = xn[i]; if (MODE != 0) zr[i] = zn[i]; }
        { const int nrow = row + rstride;
          if (nrow < T_TOK) { load_row_nt(xin + (size_t)nrow * DM, lane, xn);
            if (MODE != 0) {
#pragma unroll
                for (int i = 0; i < 4; ++i) zn[i] = __builtin_nontemporal_load((const u32x2*)(z + (size_t)nrow * DM + lane * 4 + i * 256)); } } }
        if (MODE == 0) {
            const float r = rsqrtf(row_ss(xv) * (1.f / 1024.f) + 1e-6f);
#pragma unroll
            for (int i = 0; i < 4; ++i) hv[i] = xv[i] * r * gav[i];
        } else {
            f32x4 zv[4];
#pragma unroll
            for (int i = 0; i < 4; ++i) zv[i] = (f32x4){lo16(zr[i].x), hi16(zr[i].x), lo16(zr[i].y), hi16(zr[i].y)};
            const float rz = rsqrtf(row_ss(zv) * (1.f / 1024.f) + 1e-6f);
#pragma unroll
            for (int i = 0; i < 4; ++i) { xv[i] = xv[i] + zv[i] * rz * gav[i]; __builtin_nontemporal_store(xv[i], (f32x4*)(xo + (size_t)row * DM + lane * 4 + i * 256)); }
            if (MODE == 1) {
                const float r = rsqrtf(row_ss(xv) * (1.f / 1024.f) + 1e-6f);
#pragma unroll
                for (int i = 0; i < 4; ++i) hv[i] = xv[i] * r * gbv[i];
            }
        }
        if (MODE != 2) {
#pragma unroll
            for (int i = 0; i < 4; ++i) { u32x2 w; w.x = pk2(hv[i][0], hv[i][1]); w.y = pk2(hv[i][2], hv[i][3]); *(u32x2*)(hdst + (size_t)row * DM + lane * 4 + i * 256) = w; }
        }
        if (GATES) {
            float gsum[8];
#pragma unroll
            for (int j = 0; j < 8; ++j) gsum[j] = 0.f;
#pragma unroll
            for (int i = 0; i < 4; ++i)
#pragma unroll
                for (int e = 0; e < 4; ++e) { const int k = lane * 4 + i * 256 + e; const f32x4 w0 = *(const f32x4*)(wgl + k * 8), w1 = *(const f32x4*)(wgl + k * 8 + 4); const float hvv = hv[i][e];
                    gsum[0] += hvv * w0[0]; gsum[1] += hvv * w0[1]; gsum[2] += hvv * w0[2]; gsum[3] += hvv * w0[3];
                    gsum[4] += hvv * w1[0]; gsum[5] += hvv * w1[1]; gsum[6] += hvv * w1[2]; gsum[7] += hvv * w1[3];
                    __builtin_amdgcn_sched_barrier(0); }
#pragma unroll
            for (int j = 0; j < 8; ++j) gsum[j] = wave_sum(gsum[j]);
            if (lane == 0) { f32x4 a = {gsum[0], gsum[1], gsum[2], gsum[3]}, b = {gsum[4], gsum[5], gsum[6], gsum[7]}; *(f32x4*)(g32 + (size_t)row * 8) = a; *(f32x4*)(g32 + (size_t)row * 8 + 4) = b; }
        }
    }
}

DI TileDesc prep_tile(const Params& p, int t) {
    unsigned char* ws = p.ws;
    const int nt0 = 16 * 80, nt1 = nt0 + 24 * 16, nt2 = nt1 + 16 * 64, nt3 = nt2 + 64 * 16, nt4 = nt3 + 16 * 48, nt5 = nt4 + 16 * 16, nt6 = nt5 + 16 * 64;
    const float* W; int ldw, K, NT, local; bf16_t* Wt;
    if (t < nt0)      { W = p.ev_w_in;  ldw = 5120; K = 1024; NT = 80; Wt = (bf16_t*)(ws + W_IN0);  local = t; }
    else if (t < nt1) { W = p.ev_w_out; ldw = 1024; K = 1536; NT = 16; Wt = (bf16_t*)(ws + W_OUT0); local = t - nt0; }
    else if (t < nt2) { W = p.mlp_w1;   ldw = 4096; K = 1024; NT = 64; Wt = (bf16_t*)(ws + W_UP0);  local = t - nt1; }
    else if (t < nt3) { W = p.mlp_w2;   ldw = 1024; K = 4096; NT = 16; Wt = (bf16_t*)(ws + W_DN0);  local = t - nt2; }
    else if (t < nt4) { W = p.od_w_in;  ldw = 3080; K = 1024; NT = 48; Wt = (bf16_t*)(ws + W_IN1);  local = t - nt3; }
    else if (t < nt5) { W = p.od_w_out; ldw = 1024; K = 1024; NT = 16; Wt = (bf16_t*)(ws + W_OUT1); local = t - nt4; }
    else if (t < nt6) { W = p.mlp_w1 + (size_t)1024 * 4096; ldw = 4096; K = 1024; NT = 64; Wt = (bf16_t*)(ws + W_UP1); local = t - nt5; }
    else              { W = p.mlp_w2 + (size_t)4096 * 1024; ldw = 1024; K = 4096; NT = 16; Wt = (bf16_t*)(ws + W_DN1); local = t - nt6; }
    TileDesc d; d.W = W; d.Wt = Wt; d.ldw = ldw; d.K = K; d.k0 = (local / NT) * 64; d.n0 = (local % NT) * 64; return d;
}
DI void prep_phase(const Params& p) {
    unsigned char* ws = p.ws;
    const int NTILES = 16 * 80 + 24 * 16 + 16 * 64 + 64 * 16 + 16 * 48 + 16 * 16 + 16 * 64 + 64 * 16;
    float* tl = (float*)smem;
    const int tid = ltid();
    f32x4 rv[2];
    int t = blockIdx.x;
    TileDesc cur = prep_tile(p, t < NTILES ? t : 0);
    if (t < NTILES) {
#pragma unroll
        for (int i = 0; i < 2; ++i) { const int idx = tid + i * 512, kk = idx >> 4, n4 = (idx & 15) * 4; rv[i] = __builtin_nontemporal_load((const f32x4*)(cur.W + (size_t)(cur.k0 + kk) * cur.ldw + cur.n0 + n4)); }
    }
    for (; t < NTILES; t += gridDim.x) {
#pragma unroll
        for (int i = 0; i < 2; ++i) { const int idx = tid + i * 512, kk = idx >> 4, n4 = (idx & 15) * 4;
            tl[kk * 65 + n4] = rv[i][0]; tl[kk * 65 + n4 + 1] = rv[i][1]; tl[kk * 65 + n4 + 2] = rv[i][2]; tl[kk * 65 + n4 + 3] = rv[i][3]; }
        lds_barrier();
        const int tn = t + gridDim.x;
        TileDesc nxt = prep_tile(p, tn < NTILES ? tn : 0);
        if (tn < NTILES) {
#pragma unroll
            for (int i = 0; i < 2; ++i) { const int idx = tid + i * 512, kk = idx >> 4, n4 = (idx & 15) * 4; rv[i] = __builtin_nontemporal_load((const f32x4*)(nxt.W + (size_t)(nxt.k0 + kk) * nxt.ldw + nxt.n0 + n4)); }
        }
        { const int nn = tid >> 3, k8 = (tid & 7) * 8; u32x4 w;
          w.x = pk2(tl[(k8 + 0) * 65 + nn], tl[(k8 + 1) * 65 + nn]); w.y = pk2(tl[(k8 + 2) * 65 + nn], tl[(k8 + 3) * 65 + nn]);
          w.z = pk2(tl[(k8 + 4) * 65 + nn], tl[(k8 + 5) * 65 + nn]); w.w = pk2(tl[(k8 + 6) * 65 + nn], tl[(k8 + 7) * 65 + nn]);
          *(u32x4*)(cur.Wt + (size_t)(cur.n0 + nn) * cur.K + cur.k0 + k8) = w; }
        lds_barrier();
        cur = nxt;
    }
    row_phase<0, false>(nullptr, p.x, nullptr, p.norm_g, nullptr, (bf16_t*)(ws + O_H16A), nullptr, nullptr);
}

constexpr int QS = 136, PS = 72;
constexpr int L_QE = 0, L_KE = 17408, L_VV = 34816, L_PP = 68608, L_SM = 77824, L_CW = 90112;
constexpr int SM_ALPHA = 0, SM_BETA = 256, SM_WROW = 512, SM_DEN = 768, SM_SS = 1024, SM_EMR = 1280, SM_INVF = 1536, SM_SEG = 2048, SM_NPR = 4096, SM_GN = 4608, SM_GB = 5632;

DI bf16x8 trfrag(const bf16_t* img, int rs, int s0, int c0, int lane) {
    const int g = lane >> 4, q = (lane & 15) >> 2, pp = lane & 3;
    const bf16_t* a = img + (s0 + g * 8 + q) * rs + c0 + 4 * pp;
    const s16x4 lo = __builtin_amdgcn_ds_read_tr16_b64_v4i16((LAS s16x4*)a);
    const s16x4 hi = __builtin_amdgcn_ds_read_tr16_b64_v4i16((LAS s16x4*)(a + 4 * rs));
    return __builtin_shufflevector(lo, hi, 0, 1, 2, 3, 4, 5, 6, 7);
}
#define MFMA16(a, b, c) __builtin_amdgcn_mfma_f32_16x16x32_bf16((a), (b), (c), 0, 0, 0)

#define SLA(base, row, col) ((base) + (size_t)((col) >> 7) * SLS + (size_t)(row) * 128 + ((col) & 127))
template <int MIX> struct MixC { static constexpr int DV = (MIX == 0) ? 128 : 256; };

template <int MIX, bool PASS3>
DI void chunk_phase(const Params& p) {
    constexpr int DV = MixC<MIX>::DV, VS = DV + 8, NT = DV / 128, EPC = DV * 128, OS = DV + 4;
    constexpr int NVL = DV / 64;
    constexpr bool VPRE = true;
    constexpr int gcol0 = (MIX == 0) ? 1536 : (MIX == 1) ? 4096 : 2048;
    constexpr int VPR = DV / 8, NJ = (64 * VPR) / 512;
    constexpr int vcol0 = (MIX == 0) ? 1024 : (MIX == 1) ? 3072 : 1024;
    int tid = ltid(), lane = tid & 63, wid = tid >> 6, fr = lane & 15, fq = lane >> 4;
    const int G = gridDim.x;
    unsigned char* ws = p.ws;
    bf16_t* QE = (bf16_t*)(smem + L_QE); bf16_t* KE = (bf16_t*)(smem + L_KE); bf16_t* VV = (bf16_t*)(smem + L_VV); bf16_t* PP = (bf16_t*)(smem + L_PP);
    float* alpha = (float*)(smem + L_SM + SM_ALPHA); float* beta = (float*)(smem + L_SM + SM_BETA); float* wrow = (float*)(smem + L_SM + SM_WROW);
    float* den = (float*)(smem + L_SM + SM_DEN); float* ssq = (float*)(smem + L_SM + SM_SS); float* emr = (float*)(smem + L_SM + SM_EMR);
    float* invf = (float*)(smem + L_SM + SM_INVF); float* segsum = (float*)(smem + L_SM + SM_SEG); float* nprl = (float*)(smem + L_SM + SM_NPR); float* gnl = (float*)(smem + L_SM + SM_GN); float* gbl = (float*)(smem + L_SM + SM_GB);
    float* OL = (float*)smem;
    const bf16_t* P16 = (const bf16_t*)(ws + (MIX == 2 ? O_P16_L1 : O_P16_L0));
    constexpr int LDP = (MIX == 2) ? 3072 : 5120;
    bf16_t* ST = (bf16_t*)(ws + (MIX == 2 ? O_ST_L1 : O_ST_L0));
    bf16_t* Y16 = (MIX == 2) ? (bf16_t*)(ws + O_Y16_L1) : (bf16_t*)p.out;
    constexpr int LDY = (MIX == 2) ? 1024 : 1536;
    float* G32 = (float*)(ws + O_G32); float* HGDEC = (float*)(ws + O_HGDEC); float* NLOC = (float*)(ws + O_NLOC); float* NPREV = (float*)(ws + O_NPREV);
    float* BLAST = (float*)(ws + O_SCAL); float* MLOC = BLAST + 2048; float* MPREV = BLAST + 4096;
    bf16_t* QKC = (bf16_t*)(ws + O_H16B);
    int v0 = wid * (DV / 8);

    if (MIX == 1) { if (tid < 64) invf[tid] = powf(10000.f, -(float)tid / 64.f); }
    if (PASS3) { const float* gn = (MIX == 0) ? p.ev_hg_g : (MIX == 1) ? p.ev_ret_g : p.od_ml_g; if (tid < DV) gnl[tid] = gn[tid]; }
    if (MIX == 2) { if (tid < 8) gbl[tid] = p.od_gate_b[tid]; }
    float* cwl = (float*)(smem + L_CW);
    if (MIX == 2 && !PASS3) {
        for (int i = tid; i < 4096; i += 512) cwl[i] = p.od_conv_w[i];
        for (int i = tid; i < 1024; i += 512) cwl[4096 + i] = p.od_conv_b[i];
    }
    __syncthreads();

    bf16x8 sbn[NT][4]; u32x4 gtn[NJ]; u32x4 vld[NVL];
    bf16_t hfr[16], hqr[16]; float rf0 = 0.f, rf1 = 0.f, rf2 = 0.f, rf3 = 0.f;
    u32x4 cr[7];
    u32x4 ra0, ra1, ra2, ra3;

    auto issue_sb = [&](int it) {
        const bf16_t* STi = ST + (size_t)it * EPC;
#pragma unroll
        for (int n = 0; n < NT; ++n)
#pragma unroll
            for (int kk = 0; kk < 4; ++kk) sbn[n][kk] = __builtin_nontemporal_load((const bf16x8*)(STi + ((((wid * NT + n) * 4 + kk) * 64 + lane) << 3)));
    };
    auto issue_gt = [&](int it) {
        const int c = it & 255, bh = it >> 8, b = bh >> 2, h = bh & 3;
        const int r0 = b * SEQ + c * 64;
#pragma unroll
        for (int j = 0; j < NJ; ++j) { const int idx = tid + j * 512, t = (idx >> 4) & 63, v8 = (idx >> 10) * 128 + (idx & 15) * 8;
            gtn[j] = __builtin_nontemporal_load((const u32x4*)SLA(P16, r0 + t, gcol0 + h * DV + v8)); }
    };
    auto issue = [&](int it) {
        const int c = it & 255, bh = it >> 8, b = bh >> 2, h = bh & 3;
        const int r0 = b * SEQ + c * 64;
        if (VPRE) {
#pragma unroll
            for (int j = 0; j < NVL; ++j) { const int idx = tid + j * 512, t = (idx >> 4) & 63, v8 = (idx >> 10) * 128 + (idx & 15) * 8;
                vld[j] = __builtin_nontemporal_load((const u32x4*)SLA(P16, r0 + t, vcol0 + h * DV + v8)); }
        }
        if (MIX == 0) {
            const int d = tid & 127, seg = tid >> 7, hd = h * 128 + d;
            rf0 = p.hg_lb[hd]; rf1 = p.hg_lb[512 + hd]; rf2 = p.hg_lb[1024 + hd];
            const bf16_t* basef = SLA(P16, r0 + seg * 16, 512 + hd); const bf16_t* baseq = SLA(P16, r0 + seg * 16, hd);
#pragma unroll
            for (int i = 0; i < 16; ++i) { hfr[i] = __builtin_nontemporal_load(basef + i * 128); if (PASS3) hqr[i] = __builtin_nontemporal_load(baseq + i * 128); }
        } else if (MIX == 1) {
            const int t = tid >> 3, i0 = (tid & 7) * 8;
            ra0 = __builtin_nontemporal_load((const u32x4*)SLA(P16, r0 + t, 2560 + h * 128 + i0)); ra1 = __builtin_nontemporal_load((const u32x4*)SLA(P16, r0 + t, 2560 + h * 128 + 64 + i0));
            if (PASS3) { ra2 = __builtin_nontemporal_load((const u32x4*)SLA(P16, r0 + t, 2048 + h * 128 + i0)); ra3 = __builtin_nontemporal_load((const u32x4*)SLA(P16, r0 + t, 2048 + h * 128 + 64 + i0)); }
        } else {
            const int r = r0 + lane;
            rf0 = G32[(size_t)r * 8 + h]; rf1 = G32[(size_t)r * 8 + 4 + h];
            if (!PASS3) {
                const int cg = tid & 31, t0 = (tid >> 5) * 4, col = (cg >> 4) * 512 + h * 128 + (cg & 15) * 8;
#pragma unroll
                for (int i = 0; i < 7; ++i) { const int tok = c * 64 + t0 - 3 + i;
                    cr[i] = (u32x4){0u, 0u, 0u, 0u};
                    if (tok >= 0) cr[i] = *(const u32x4*)SLA(P16, b * SEQ + tok, col); }
            }
            if (PASS3) {
                rf2 = MPREV[it]; if (tid < 128) rf3 = NPREV[(size_t)it * 128 + tid];
                { const int tt = tid >> 4, c8 = (tid & 15) * 8; ra0 = __builtin_nontemporal_load((const u32x4*)SLA(QKC, r0 + tt, h * 128 + c8)); ra2 = __builtin_nontemporal_load((const u32x4*)SLA(QKC, r0 + tt, 512 + h * 128 + c8)); }
                { const int tt = (tid + 512) >> 4, c8 = (tid & 15) * 8; ra1 = __builtin_nontemporal_load((const u32x4*)SLA(QKC, r0 + tt, h * 128 + c8)); ra3 = __builtin_nontemporal_load((const u32x4*)SLA(QKC, r0 + tt, 512 + h * 128 + c8)); }
            }
        }
    };

    auto transform = [&](int it) {
        const int c = it & 255, bh = it >> 8, b = bh >> 2, h = bh & 3;
        const int r0 = b * SEQ + c * 64;
        if (MIX == 0) {
            const int d = tid & 127, seg = tid >> 7;
            const float mx = fmaxf(rf0, fmaxf(rf1, rf2)); const float e0 = __expf(rf0 - mx), e1 = __expf(rf1 - mx), e2 = __expf(rf2 - mx);
            const float lb = e0 * __builtin_amdgcn_rcpf(e0 + e1 + e2);
            float pc[16], kk_[16]; float run = 1.f;
#pragma unroll
            for (int i = 0; i < 16; ++i) { const float xf = bf2f(hfr[i]); const float f = lb + (1.f - lb) * sigmf(xf); run *= f; pc[i] = run; kk_[i] = 1.f - f; }
            segsum[seg * 128 + d] = run;
            lds_barrier();
            float off = 1.f, tot = 1.f;
#pragma unroll
            for (int s2 = 0; s2 < 4; ++s2) { const float v = segsum[s2 * 128 + d]; tot *= v; if (s2 < seg) off *= v; }
#pragma unroll
            for (int i = 0; i < 16; ++i) { const float pb = off * pc[i]; const int t = seg * 16 + i;
                const float rpb = __builtin_amdgcn_rcpf(fmaxf(pb, 1e-35f));
                if (PASS3) { const float q = siluf(bf2f(hqr[i]));
                    QE[t * QS + d] = f2bf(q * pb); KE[t * QS + d] = f2bf(kk_[i] * rpb); }
                else KE[t * QS + d] = f2bf(kk_[i] * tot * rpb); }
            if (!PASS3 && seg == 0) HGDEC[(size_t)it * 128 + d] = tot;
        } else if (MIX == 1) {
            const float lg = log1pf(-exp2f(-5.f - (float)h));
            const int t = tid >> 3, i0 = (tid & 7) * 8, pos = c * 64 + t;
            const u32x4 k1 = ra0, k2 = ra1, q1 = PASS3 ? ra2 : ra0, q2 = PASS3 ? ra3 : ra1;
            const float ksc = 0.08838834764831845f * (PASS3 ? 1.f : __expf(lg * (float)(63 - t)));
            u32x4 qa, qb, ka, kb;
#pragma unroll
            for (int jj = 0; jj < 4; ++jj) {
                float cs[2], sn[2];
#pragma unroll
                for (int e = 0; e < 2; ++e) { double rev = (double)pos * (double)invf[i0 + jj * 2 + e] * 0.15915494309189535; rev -= rint(rev); const float frc = (float)rev;
                    sn[e] = __builtin_amdgcn_sinf(frc); cs[e] = __builtin_amdgcn_cosf(frc); }
                { const float x1l = lo16(k1[jj]), x1h = hi16(k1[jj]), x2l = lo16(k2[jj]), x2h = hi16(k2[jj]);
                  ka[jj] = pk2((x1l * cs[0] - x2l * sn[0]) * ksc, (x1h * cs[1] - x2h * sn[1]) * ksc);
                  kb[jj] = pk2((x2l * cs[0] + x1l * sn[0]) * ksc, (x2h * cs[1] + x1h * sn[1]) * ksc); }
                if (PASS3) { const float x1l = lo16(q1[jj]), x1h = hi16(q1[jj]), x2l = lo16(q2[jj]), x2h = hi16(q2[jj]);
                  qa[jj] = pk2(x1l * cs[0] - x2l * sn[0], x1h * cs[1] - x2h * sn[1]);
                  qb[jj] = pk2(x2l * cs[0] + x1l * sn[0], x2h * cs[1] + x1h * sn[1]); }
            }
            *(u32x4*)(KE + t * QS + i0) = ka; *(u32x4*)(KE + t * QS + 64 + i0) = kb;
            if (PASS3) { *(u32x4*)(QE + t * QS + i0) = qa; *(u32x4*)(QE + t * QS + 64 + i0) = qb; }
            if (PASS3 && tid < 64) { alpha[tid] = lg * (float)tid; beta[tid] = -lg * (float)tid; wrow[tid] = __expf(lg * (float)(tid + 1)); }
        } else {
            const float igp = rf0 + gbl[h], fgp = rf1 + gbl[4 + h];
            const float ig = 15.f * tanh_fast(igp * (1.f / 15.f)); const float fc = 15.f * tanh_fast(fgp * (1.f / 15.f));
            const float lf = -log1p_fast(__expf(-fc));
            const float bc = wave_scan_sum(lf);
            const float blast = rdlane(bc, 63);
            if (!PASS3) {
                const float lwe = blast - bc + ig; const float ml = rdlane(wave_scan_max(lwe), 63);
                const float ksc = expf(lwe - ml);
                if (tid == 0) { BLAST[it] = blast; MLOC[it] = ml; }
                {
                    const int cg = tid & 31, t0 = (tid >> 5) * 4, which = cg >> 4, c8 = (cg & 15) * 8, col = which * 512 + h * 128 + c8;
                    float wv[4][8], bv[8];
#pragma unroll
                    for (int jj = 0; jj < 4; ++jj) { const f32x4 w0 = *(const f32x4*)(cwl + jj * 1024 + col), w1 = *(const f32x4*)(cwl + jj * 1024 + col + 4);
                        wv[jj][0] = w0[0]; wv[jj][1] = w0[1]; wv[jj][2] = w0[2]; wv[jj][3] = w0[3]; wv[jj][4] = w1[0]; wv[jj][5] = w1[1]; wv[jj][6] = w1[2]; wv[jj][7] = w1[3]; }
                    { const f32x4 b0 = *(const f32x4*)(cwl + 4096 + col), b1 = *(const f32x4*)(cwl + 4096 + col + 4);
                      bv[0] = b0[0]; bv[1] = b0[1]; bv[2] = b0[2]; bv[3] = b0[3]; bv[4] = b1[0]; bv[5] = b1[1]; bv[6] = b1[2]; bv[7] = b1[3]; }
                    const float sc = (which == 1) ? 0.08838834764831845f : 1.f;
#pragma unroll
                    for (int i = 0; i < 4; ++i) {
                        const int t = t0 + i;
                        float acc[8];
#pragma unroll
                        for (int e = 0; e < 8; ++e) acc[e] = bv[e];
#pragma unroll
                        for (int jj = 0; jj < 4; ++jj) { const u32x4 xv = cr[i + jj];
                            acc[0] += wv[jj][0] * lo16(xv[0]); acc[1] += wv[jj][1] * hi16(xv[0]); acc[2] += wv[jj][2] * lo16(xv[1]); acc[3] += wv[jj][3] * hi16(xv[1]);
                            acc[4] += wv[jj][4] * lo16(xv[2]); acc[5] += wv[jj][5] * hi16(xv[2]); acc[6] += wv[jj][6] * lo16(xv[3]); acc[7] += wv[jj][7] * hi16(xv[3]); }
#pragma unroll
                        for (int e = 0; e < 8; ++e) acc[e] = siluf(acc[e]) * sc;
                        u32x4 w; w.x = pk2(acc[0], acc[1]); w.y = pk2(acc[2], acc[3]); w.z = pk2(acc[4], acc[5]); w.w = pk2(acc[6], acc[7]);
                        __builtin_nontemporal_store(w, (u32x4*)SLA(QKC, r0 + t, col));
                        const float ks = __shfl(ksc, t);
                        if (which == 1) { u32x4 w2; w2.x = pk2(acc[0] * ks, acc[1] * ks); w2.y = pk2(acc[2] * ks, acc[3] * ks); w2.z = pk2(acc[4] * ks, acc[5] * ks); w2.w = pk2(acc[6] * ks, acc[7] * ks);
                            *(u32x4*)(KE + t * QS + c8) = w2; }
                    }
                }
            } else {
                const float mprev = rf2; const float inter = bc + mprev; const float bt = ig - bc; const float bm = wave_scan_max(bt);
                const float mrow = fmaxf(inter, bc + bm);
                if (wid == 0) { alpha[lane] = bc - mrow; beta[lane] = bt; wrow[lane] = expf(inter - mrow); emr[lane] = expf(-mrow); }
                if (tid < 128) nprl[tid] = rf3;
                { const int tt = tid >> 4, c8 = (tid & 15) * 8; *(u32x4*)(QE + tt * QS + c8) = ra0; *(u32x4*)(KE + tt * QS + c8) = ra2; }
                { const int tt = (tid + 512) >> 4, c8 = (tid & 15) * 8; *(u32x4*)(QE + tt * QS + c8) = ra1; *(u32x4*)(KE + tt * QS + c8) = ra3; }
            }
        }
#pragma unroll
        for (int j = 0; j < NVL; ++j) { const int idx = tid + j * 512, t = (idx >> 4) & 63, v8 = (idx >> 10) * 128 + (idx & 15) * 8;
            *(u32x4*)(VV + t * VS + v8) = VPRE ? vld[j] : *(const u32x4*)SLA(P16, r0 + t, vcol0 + h * DV + v8); }
        if (PASS3 && tid < 64) ssq[tid] = 0.f;
    };

    int it = blockIdx.x;
    if (it < 2048) { issue(it); if (PASS3) { issue_sb(it); issue_gt(it); } }
    for (; it < 2048; it += G) {
        tid = ltid(); lane = tid & 63; wid = tid >> 6; fr = lane & 15; fq = lane >> 4; v0 = wid * (DV / 8);
        const int c = it & 255, bh = it >> 8, b = bh >> 2, h = bh & 3;
        const int r0 = b * SEQ + c * 64;
        bf16_t* STi = ST + (size_t)it * EPC;
        transform(it);
        lds_barrier();
        if (it + G < 2048) issue(it + G);
        __builtin_amdgcn_sched_barrier(0);

        if (!PASS3) {
            constexpr int MT = DV / 128;
            f32x4 acc[MT][8];
#pragma unroll
            for (int m = 0; m < MT; ++m)
#pragma unroll
                for (int n = 0; n < 8; ++n) acc[m][n] = (f32x4){0.f, 0.f, 0.f, 0.f};
#pragma unroll
            for (int ks = 0; ks < 2; ++ks) {
                bf16x8 va[MT];
#pragma unroll
                for (int m = 0; m < MT; ++m) va[m] = trfrag(VV, VS, ks * 32, v0 + m * 16, lane);
#pragma unroll
                for (int n = 0; n < 8; ++n) { const bf16x8 kb = trfrag(KE, QS, ks * 32, n * 16, lane);
#pragma unroll
                    for (int m = 0; m < MT; ++m) acc[m][n] = MFMA16(kb, va[m], acc[m][n]); }
            }
#pragma unroll
            for (int m = 0; m < MT; ++m)
#pragma unroll
                for (int n = 0; n < 8; ++n) { u32x2 w; w.x = pk2(acc[m][n][0], acc[m][n][1]); w.y = pk2(acc[m][n][2], acc[m][n][3]);
                    *(u32x2*)(STi + ((((wid * NT + m) * 4 + (n >> 1)) * 64 + ((n & 1) * 2 + (fq >> 1)) * 16 + fr) << 3) + (fq & 1) * 4) = w; }
            if (MIX == 2 && tid < 128) { float s = 0.f;
#pragma unroll 8
                for (int t = 0; t < 64; ++t) s += bf2f(KE[t * QS + tid]);
                NLOC[(size_t)it * 128 + tid] = s; }
            lds_barrier();
        } else {
            {
                const int ti = wid >> 1;
#pragma unroll
                for (int sj = 0; sj < 2; ++sj) {
                    const int si = (wid & 1) * 2 + sj;
                    f32x4 acc = {0.f, 0.f, 0.f, 0.f};
                    if (si <= ti) {
#pragma unroll
                        for (int kk = 0; kk < 4; ++kk) { const bf16x8 a = *(const bf16x8*)(QE + (ti * 16 + fr) * QS + kk * 32 + fq * 8); const bf16x8 bb = *(const bf16x8*)(KE + (si * 16 + fr) * QS + kk * 32 + fq * 8);
                            acc = MFMA16(a, bb, acc); }
                    }
                    const int s = si * 16 + fr; const float be = (MIX == 0) ? 0.f : beta[s];
#pragma unroll
                    for (int j = 0; j < 4; ++j) { const int t = ti * 16 + fq * 4 + j; float v = 0.f;
                        if (si <= ti && s <= t) v = (MIX == 0) ? acc[j] : acc[j] * __expf(alpha[t] + be);
                        PP[t * PS + s] = f2bf(v); }
                }
            }
            lds_barrier();
            if (MIX == 2) {
                const int t = tid >> 3, part = tid & 7;
                const bf16x8 pv = *(const bf16x8*)(PP + t * PS + part * 8);
                float sp = 0.f, qn = 0.f;
#pragma unroll
                for (int e = 0; e < 8; ++e) sp += bf2f((bf16_t)pv[e]);
#pragma unroll
                for (int g2 = 0; g2 < 2; ++g2) { const bf16x8 qv = *(const bf16x8*)(QE + t * QS + part * 16 + g2 * 8);
#pragma unroll
                    for (int e = 0; e < 8; ++e) qn += bf2f((bf16_t)qv[e]) * nprl[part * 16 + g2 * 8 + e]; }
                sp += wrow[t] * qn;
                sp += DPPF(0.f, sp, 0xB1, 0xf); sp += DPPF(0.f, sp, 0x4E, 0xf); sp += DPPF(0.f, sp, 0x141, 0xf);
                if (part == 0) den[t] = sp;
            }
            __builtin_amdgcn_sched_barrier(0);
            f32x4 acc[4][NT];
#pragma unroll
            for (int ti = 0; ti < 4; ++ti)
#pragma unroll
                for (int n = 0; n < NT; ++n) acc[ti][n] = (f32x4){0.f, 0.f, 0.f, 0.f};
#pragma unroll
            for (int kk = 0; kk < 4; ++kk)
#pragma unroll
                for (int ti = 0; ti < 4; ++ti) { const bf16x8 a = *(const bf16x8*)(QE + (ti * 16 + fr) * QS + kk * 32 + fq * 8);
#pragma unroll
                    for (int n = 0; n < NT; ++n) acc[ti][n] = MFMA16(a, sbn[n][kk], acc[ti][n]); }
            __builtin_amdgcn_sched_barrier(0);
            if (it + G < 2048) issue_sb(it + G);
            __builtin_amdgcn_sched_barrier(0);
            if (MIX != 0) {
#pragma unroll
                for (int ti = 0; ti < 4; ++ti)
#pragma unroll
                    for (int j = 0; j < 4; ++j) { const float w = wrow[ti * 16 + fq * 4 + j];
#pragma unroll
                        for (int n = 0; n < NT; ++n) acc[ti][n][j] *= w; }
            }
#pragma unroll
            for (int ks = 0; ks < 2; ++ks) {
                bf16x8 vb[NT];
#pragma unroll
                for (int n = 0; n < NT; ++n) vb[n] = trfrag(VV, VS, ks * 32, v0 + n * 16, lane);
#pragma unroll
                for (int ti = 0; ti < 4; ++ti) { const bf16x8 a = *(const bf16x8*)(PP + (ti * 16 + fr) * PS + ks * 32 + fq * 8);
#pragma unroll
                    for (int n = 0; n < NT; ++n) acc[ti][n] = MFMA16(a, vb[n], acc[ti][n]); }
            }
            lds_barrier();
#pragma unroll
            for (int ti = 0; ti < 4; ++ti)
#pragma unroll
                for (int j = 0; j < 4; ++j) { const int t = ti * 16 + fq * 4 + j; float s = 0.f;
                    float inv = 1.f;
                    if (MIX == 2) inv = __builtin_amdgcn_rcpf(fmaxf(fabsf(den[t]), emr[t]));
#pragma unroll
                    for (int n = 0; n < NT; ++n) { const float o = acc[ti][n][j] * inv; OL[t * OS + v0 + n * 16 + fr] = o; s += o * o; }
                    s = row16_sum(s);
                    if (fr == 0) atomicAdd(&ssq[t], s); }
            lds_barrier();
            {
                constexpr int ycol0 = (MIX == 1) ? 512 : 0;
#pragma unroll
                for (int j = 0; j < NJ; ++j) {
                    const int idx = tid + j * 512, t = (idx >> 4) & 63, v8 = (idx >> 10) * 128 + (idx & 15) * 8;
                    const float rstd = rsqrtf(ssq[t] * (1.f / (float)DV) + 1e-6f);
                    const u32x4 gt = gtn[j];
                    const f32x4 o0 = *(const f32x4*)(OL + t * OS + v8), o1 = *(const f32x4*)(OL + t * OS + v8 + 4);
                    const f32x4 g0 = *(const f32x4*)(gnl + v8), g1 = *(const f32x4*)(gnl + v8 + 4);
                    float gv[8] = {lo16(gt[0]), hi16(gt[0]), lo16(gt[1]), hi16(gt[1]), lo16(gt[2]), hi16(gt[2]), lo16(gt[3]), hi16(gt[3])};
                    float y[8];
#pragma unroll
                    for (int e = 0; e < 8; ++e) { const float o = (e < 4) ? o0[e & 3] : o1[e & 3]; const float g = (e < 4) ? g0[e & 3] : g1[e & 3];
                        const float act = (MIX == 2) ? sigmf(gv[e]) : siluf(gv[e]);
                        y[e] = o * rstd * g * act; }
                    u32x4 w; w.x = pk2(y[0], y[1]); w.y = pk2(y[2], y[3]); w.z = pk2(y[4], y[5]); w.w = pk2(y[6], y[7]);
                    *(u32x4*)(Y16 + (size_t)(r0 + t) * LDY + ycol0 + h * DV + v8) = w;
                }
            }
            if (it + G < 2048) issue_gt(it + G);
            lds_barrier();
        }
    }
}

template <int MIX>
DI void scan_phase(const Params& p) {
    constexpr int DV = MixC<MIX>::DV, EPC = DV * 128, HPC = EPC / 2, SU = 16;
    unsigned char* ws = p.ws;
    bf16_t* ST = (bf16_t*)(ws + (MIX == 2 ? O_ST_L1 : O_ST_L0));
    const float* HGDEC = (const float*)(ws + O_HGDEC); const float* NLOC = (const float*)(ws + O_NLOC); float* NPREV = (float*)(ws + O_NPREV);
    const float* BLAST = (const float*)(ws + O_SCAL); const float* MLOC = BLAST + 2048; float* MPREV = (float*)(ws + O_SCAL) + 4096;
    for (int e = blockIdx.x * 512 + ltid(); e < 8 * HPC; e += gridDim.x * 512) {
        const int chain = e / HPC, off = (e % HPC) * 2, v = off >> 7;
        const int d = (MIX == 0) ? ((((off >> 9) & 3) << 5) + (((off >> 7) & 3) << 3) + (off & 7)) : (off & 127);
        bf16_t* base = ST + (size_t)chain * 256 * EPC + off;
        float s0 = 0.f, s1 = 0.f, m = 0.f, n0 = 0.f, n1 = 0.f;
        float cd = 1.f;
        if (MIX == 1) cd = __expf(64.f * log1pf(-exp2f(-5.f - (float)(chain & 3))));
        unsigned hv[SU], hn[SU]; float dx[SU], dy[SU], dxn[SU], dyn[SU];
#define SCAN_LOAD(H, DX, DY, C0) do { _Pragma("unroll") for (int u = 0; u < SU; ++u) { H[u] = __builtin_nontemporal_load((const unsigned*)(base + (size_t)((C0) + u) * EPC)); \
            if (MIX == 0) { const float2 dd = *(const float2*)(HGDEC + (size_t)(chain * 256 + (C0) + u) * 128 + d); DX[u] = dd.x; DY[u] = dd.y; } \
            if (MIX == 2) { DX[u] = BLAST[chain * 256 + (C0) + u]; DY[u] = MLOC[chain * 256 + (C0) + u]; } } } while (0)
        SCAN_LOAD(hv, dx, dy, 0);
        for (int c0 = 0; c0 < 256; c0 += SU) {
            if (c0 + SU < 256) SCAN_LOAD(hn, dxn, dyn, c0 + SU);
#pragma unroll
            for (int u = 0; u < SU; ++u) {
                const int ci = chain * 256 + c0 + u;
                *(unsigned*)(base + (size_t)(c0 + u) * EPC) = pk2(s0, s1);
                const float h0 = lo16(hv[u]), h1 = hi16(hv[u]);
                if (MIX == 0) { s0 = dx[u] * s0 + h0; s1 = dy[u] * s1 + h1; }
                else if (MIX == 1) { s0 = cd * s0 + h0; s1 = cd * s1 + h1; }
                else {
                    const float bl = dx[u], ml = dy[u]; const float mn = fmaxf(bl + m, ml); const float sp = __expf(bl + m - mn), sl = __expf(ml - mn);
                    if (v == 0) { *(float2*)(NPREV + (size_t)ci * 128 + d) = make_float2(n0, n1); const float2 nl = *(const float2*)(NLOC + (size_t)ci * 128 + d);
                        n0 = sp * n0 + sl * nl.x; n1 = sp * n1 + sl * nl.y; if (d == 0) MPREV[ci] = m; }
                    s0 = sp * s0 + sl * h0; s1 = sp * s1 + sl * h1; m = mn;
                }
            }
#pragma unroll
            for (int u = 0; u < SU; ++u) { hv[u] = hn[u]; dx[u] = dxn[u]; dy[u] = dyn[u]; }
        }
#undef SCAN_LOAD
    }
}

#ifndef PH_MASK
#define PH_MASK 0x3fffff
#endif
#define EN(n) if constexpr (((PH_MASK) >> (n)) & 1)
DI void run_phase(const Params& p, int ph) {
    unsigned char* ws = p.ws;
    switch (ph) {
        case 0: EN(0) prep_phase(p); break;
        case 1: case 8: case 10: case 11: case 13: case 17: case 19: case 20: EN(1) run_gemm(p, ph); break;
        case 2: EN(2) chunk_phase<0, false>(p); break;
        case 3: EN(3) scan_phase<0>(p); break;
        case 4: EN(4) chunk_phase<0, true>(p); break;
        case 5: EN(5) chunk_phase<1, false>(p); break;
        case 6: EN(6) scan_phase<1>(p); break;
        case 7: EN(7) chunk_phase<1, true>(p); break;
        case 9:  EN(9) row_phase<1, false>((const bf16_t*)(ws + O_Z32), p.x, p.out, p.norm_g + 1 * 1024, p.norm_g + 2 * 1024, (bf16_t*)(ws + O_H16B), nullptr, nullptr); break;
        case 12: EN(12) row_phase<1, true>((const bf16_t*)(ws + O_Z32), p.out, p.out, p.norm_g + 3 * 1024, p.norm_g + 4 * 1024, (bf16_t*)(ws + O_H16B), p.od_w_in, (float*)(ws + O_G32)); break;
        case 14: EN(14) chunk_phase<2, false>(p); break;
        case 15: EN(15) scan_phase<2>(p); break;
        case 16: EN(16) chunk_phase<2, true>(p); break;
        case 18: EN(18) row_phase<1, false>((const bf16_t*)(ws + O_Z32), p.out, p.out, p.norm_g + 5 * 1024, p.norm_g + 6 * 1024, (bf16_t*)(ws + O_H16B), nullptr, nullptr); break;
        case 21: EN(21) row_phase<2, false>((const bf16_t*)(ws + O_Z32), p.out, p.out, p.norm_g + 7 * 1024, nullptr, nullptr, nullptr, nullptr); break;
        default: break;
    }
}
constexpr int N_PHASES = 22;

__global__ void __launch_bounds__(512, 2) mega(Params p) {
    cg::grid_group grid = cg::this_grid();
    volatile LAS unsigned* st = (volatile LAS unsigned*)(smem + 131072);
    unsigned* bar = (unsigned*)(p.ws + O_BAR);
    if (threadIdx.x < 4) st[threadIdx.x] = 0u;
    if (blockIdx.x == 0) for (int i = threadIdx.x; i < XCD_BAR_WORDS; i += 512) bar[i] = 0u;
    __syncthreads();
    XcdBarrier xb; xb.bar = bar; xb.x = 0u; xb.st = st;
    for (int ph = p.phase_lo; ph < p.phase_hi; ++ph) {
        size_t zo = 0; asm volatile("s_mov_b64 %0, 0" : "=s"(zo));
        Params q = p;
        q.x = p.x + zo; q.norm_g = p.norm_g + zo; q.hg_lb = p.hg_lb + zo; q.ev_w_in = p.ev_w_in + zo; q.ev_hg_g = p.ev_hg_g + zo; q.ev_ret_g = p.ev_ret_g + zo; q.ev_w_out = p.ev_w_out + zo;
        q.od_w_in = p.od_w_in + zo; q.od_conv_w = p.od_conv_w + zo; q.od_conv_b = p.od_conv_b + zo; q.od_gate_b = p.od_gate_b + zo; q.od_ml_g = p.od_ml_g + zo; q.od_w_out = p.od_w_out + zo;
        q.mlp_w1 = p.mlp_w1 + zo; q.mlp_w2 = p.mlp_w2 + zo; q.out = p.out + zo; q.ws = p.ws + zo;
#ifdef REP_MASK
        for (int rep = 0; rep < 1 + (int)(((REP_MASK) >> ph) & 1); ++rep) { if (rep) __syncthreads(); run_phase(q, ph); }
#else
        run_phase(q, ph);
#endif
        if (ph + 1 < p.phase_hi) {
            if (ph == p.phase_lo) { grid.sync(); xb = xcd_barrier_post(bar, st); }
            else xcd_barrier(xb);
        }
#ifdef EXTRA_SYNC
        for (int k = 0; k < EXTRA_SYNC; ++k) xcd_barrier(xb);
#endif
    }
}

extern "C" void kernel_launch(void* const* d_in, const int* in_sizes, int n_in, void* d_out, int out_size, void* d_ws, size_t ws_size, hipStream_t stream) {
    static int grid_blocks = 0;
    if (!grid_blocks) {
        int dev = 0, cus = 0, per_cu = 0;
        hipGetDevice(&dev);
        hipDeviceGetAttribute(&cus, hipDeviceAttributeMultiprocessorCount, dev);
        hipFuncSetAttribute((const void*)mega, hipFuncAttributeMaxDynamicSharedMemorySize, LDS_BYTES);
        hipOccupancyMaxActiveBlocksPerMultiprocessor(&per_cu, mega, 512, LDS_BYTES);
        if (per_cu > 1) per_cu = 1;
        grid_blocks = cus * per_cu;
        if (grid_blocks <= 0) { fprintf(stderr, "occupancy query failed (cus %d per_cu %d)\n", cus, per_cu); grid_blocks = 0; return; }
    }
    if (ws_size < WS_NEED) { fprintf(stderr, "workspace too small: %zu < %zu\n", ws_size, (size_t)WS_NEED); return; }
    Params p{};
    p.x = (const float*)d_in[0]; p.norm_g = (const float*)d_in[1]; p.hg_lb = (const float*)d_in[2]; p.ev_w_in = (const float*)d_in[3]; p.ev_hg_g = (const float*)d_in[4];
    p.ev_ret_g = (const float*)d_in[5]; p.ev_w_out = (const float*)d_in[6]; p.od_w_in = (const float*)d_in[7]; p.od_conv_w = (const float*)d_in[8]; p.od_conv_b = (const float*)d_in[9];
    p.od_gate_b = (const float*)d_in[10]; p.od_ml_g = (const float*)d_in[11]; p.od_w_out = (const float*)d_in[12]; p.mlp_w1 = (const float*)d_in[13]; p.mlp_w2 = (const float*)d_in[14];
    p.out = (float*)d_out; p.ws = (unsigned char*)d_ws; p.phase_lo = 0; p.phase_hi = N_PHASES;
    void* args[] = {&p};
    hipError_t e = hipLaunchCooperativeKernel((const void*)mega, dim3(grid_blocks), dim3(512), args, LDS_BYTES, stream);
    if (e != hipSuccess) fprintf(stderr, "cooperative launch failed: %s (grid %d)\n", hipGetErrorString(e), grid_blocks);
}
```
